# Optimizing an MI355X kernel written in HIP

```python
import math
import jax, jax.numpy as jnp
from jax import lax
import numpy as np

D_MODEL = 4096
BATCH = 4
SEQ = 2048
DEPTH = 1

HEAD_DIM = 128
N_ATT_HEADS = 16
N_KV_GROUPS = 4
HEADS_PER_GROUP = N_ATT_HEADS // N_KV_GROUPS
D_ATT = N_ATT_HEADS * HEAD_DIM
D_KV = N_KV_GROUPS * HEAD_DIM
N_POOL_GROUPS = 4
POOL_WINDOWS = (2, 4, 8, 16)
D_POOL = D_MODEL - D_ATT
POOL_GROUP_DIM = D_POOL // N_POOL_GROUPS
D_MIX = D_ATT + D_POOL
CMP_BLOCK = 32
CMP_STRIDE = 16
CMP_HIDDEN = HEAD_DIM
SEL_BLOCK = 64
SEL_TOP = 8
WINDOW = 512
Q_BLOCK = 128
REL_BUCKETS = 32
REL_MAX_DIST = 128
D_FF = 11008
EPS = 1e-6
NEG = -1e30
FORCE_BONUS = 1e4
D_IN = D_ATT + 6 * D_KV + 3 * N_ATT_HEADS + D_POOL

kernel_name = "hymba_nsa_pool_macaron"


def rmsnorm(x, g):
    xf = x.astype(jnp.float32)
    y = xf * lax.rsqrt(jnp.mean(xf * xf, axis=-1, keepdims=True) + EPS)
    return (y * g.astype(jnp.float32)).astype(x.dtype)


def swiglu(x, w_gate, w_up, w_down):
    return (jax.nn.silu(x @ w_gate) * (x @ w_up)) @ w_down


def rel_bucket(dist):
    max_exact = REL_BUCKETS // 2
    n = jnp.maximum(dist, 0)
    nf = jnp.maximum(n, 1).astype(jnp.float32)
    large = max_exact + (jnp.log(nf / max_exact) / math.log(REL_MAX_DIST / max_exact)
                         * (REL_BUCKETS - max_exact)).astype(jnp.int32)
    large = jnp.minimum(large, REL_BUCKETS - 1)
    return jnp.where(n < max_exact, n, large)


def compress(kv, pos, w1, w2):
    B, S, G, dk = kv.shape
    n_cmp = (S - CMP_BLOCK) // CMP_STRIDE + 1
    idx = jnp.arange(n_cmp)[:, None] * CMP_STRIDE + jnp.arange(CMP_BLOCK)[None, :]
    blk = kv[:, idx] + pos[None, None, :, None, :]
    blk = blk.transpose(0, 3, 1, 2, 4).reshape(B, G, n_cmp, CMP_BLOCK * dk)
    return jax.nn.silu(blk @ w1) @ w2


def nsa_attention(q, k_cmp, v_cmp, k_sel, v_sel, k_win, v_win, gates,
                  cmp_pos_k, w_ck1, w_ck2, cmp_pos_v, w_cv1, w_cv2, rel_table):
    B, S, G, HPG, dk = q.shape
    H = G * HPG
    pos = jnp.arange(S)

    kc = compress(k_cmp, cmp_pos_k, w_ck1, w_ck2)
    vc = compress(v_cmp, cmp_pos_v, w_cv1, w_cv2)
    n_cmp = kc.shape[2]
    cmp_end = jnp.arange(n_cmp) * CMP_STRIDE + CMP_BLOCK - 1
    dist_c = pos[:, None] - cmp_end[None, :]
    valid_c = dist_c >= 0
    bias_c = rel_table[rel_bucket(dist_c)].transpose(2, 0, 1).reshape(G, HPG, S, n_cmp)
    logit_c = jnp.einsum('bsghd,bgcd->bghsc', q, kc).astype(jnp.float32)
    logit_c = jnp.where(valid_c, logit_c + bias_c.astype(jnp.float32), NEG)
    any_valid = jnp.any(valid_c, axis=-1)[:, None].astype(jnp.float32)
    p_c = jax.nn.softmax(logit_c, axis=-1) * any_valid
    o_cmp = jnp.einsum('bghsc,bgcd->bsghd', p_c.astype(vc.dtype), vc)

    n_sb = S // SEL_BLOCK
    cs = jnp.arange(n_cmp) * CMP_STRIDE
    ss = jnp.arange(n_sb) * SEL_BLOCK
    overlap = ((cs[:, None] < ss[None, :] + SEL_BLOCK) &
               (cs[:, None] + CMP_BLOCK > ss[None, :])).astype(jnp.float32)
    imp = jnp.einsum('bghsc,cj->bgsj', p_c, overlap)
    cur = pos // SEL_BLOCK
    jb = jnp.arange(n_sb)
    forced = (jb[None] == 0) | (jb[None] == cur[:, None]) | (jb[None] == cur[:, None] - 1)
    future = jb[None] > cur[:, None]
    score = jnp.where(future, -1e9, imp + jnp.where(forced, FORCE_BONUS, 0.0))
    top = min(SEL_TOP, n_sb)
    _, sel_idx = lax.top_k(score, top)

    ksb = k_sel.reshape(B, n_sb, SEL_BLOCK, G, dk).transpose(0, 3, 1, 2, 4)
    vsb = v_sel.reshape(B, n_sb, SEL_BLOCK, G, dk).transpose(0, 3, 1, 2, 4)
    n_qb = S // Q_BLOCK
    q_blocks = q.reshape(B, n_qb, Q_BLOCK, G, HPG, dk).transpose(1, 0, 3, 4, 2, 5)
    idx_blocks = sel_idx.reshape(B, G, n_qb, Q_BLOCK, top).transpose(2, 0, 1, 3, 4)
    qpos_blocks = pos.reshape(n_qb, Q_BLOCK)
    tab = rel_table.T.reshape(G, HPG, REL_BUCKETS)
    b_ix = jnp.arange(B)[:, None, None, None]
    g_ix = jnp.arange(G)[None, :, None, None]
    g5 = jnp.arange(G)[None, :, None, None, None]
    h5 = jnp.arange(HPG)[None, None, :, None, None]

    def sel_block(args):
        qb, ib, qpos = args
        kg = ksb[b_ix, g_ix, ib].reshape(B, G, Q_BLOCK, top * SEL_BLOCK, dk)
        vg = vsb[b_ix, g_ix, ib].reshape(B, G, Q_BLOCK, top * SEL_BLOCK, dk)
        kpos = (ib[..., None] * SEL_BLOCK + jnp.arange(SEL_BLOCK)).reshape(B, G, Q_BLOCK, top * SEL_BLOCK)
        dist = qpos[None, None, :, None] - kpos
        bias = tab[g5, h5, rel_bucket(dist)[:, :, None]]
        logit = jnp.einsum('bghqd,bgqkd->bghqk', qb, kg).astype(jnp.float32)
        logit = jnp.where((dist >= 0)[:, :, None], logit + bias.astype(jnp.float32), NEG)
        p = jax.nn.softmax(logit, axis=-1)
        return jnp.einsum('bghqk,bgqkd->bqghd', p.astype(vg.dtype), vg)

    o_sel = lax.map(sel_block, (q_blocks, idx_blocks, qpos_blocks))
    o_sel = o_sel.transpose(1, 0, 2, 3, 4, 5).reshape(B, S, G, HPG, dk)

    span = WINDOW + Q_BLOCK
    kp = jnp.pad(k_win, ((0, 0), (WINDOW, 0), (0, 0), (0, 0)))
    vp = jnp.pad(v_win, ((0, 0), (WINDOW, 0), (0, 0), (0, 0)))
    widx = jnp.arange(n_qb)[:, None] * Q_BLOCK + jnp.arange(span)[None, :]
    kw = kp[:, widx]
    vw = vp[:, widx]
    qw = q.reshape(B, n_qb, Q_BLOCK, G, HPG, dk)
    dist_w = jnp.arange(Q_BLOCK)[:, None] + WINDOW - jnp.arange(span)[None, :]
    valid_w = ((dist_w >= 0) & (dist_w < WINDOW))[None] & ((widx - WINDOW) >= 0)[:, None, :]
    bias_w = rel_table[rel_bucket(dist_w)].transpose(2, 0, 1).reshape(G, HPG, 1, Q_BLOCK, span)
    logit_w = jnp.einsum('bnqghd,bnkgd->bghnqk', qw, kw).astype(jnp.float32)
    logit_w = jnp.where(valid_w, logit_w + bias_w.astype(jnp.float32), NEG)
    p_w = jax.nn.softmax(logit_w, axis=-1)
    o_win = jnp.einsum('bghnqk,bnkgd->bnqghd', p_w.astype(vw.dtype), vw).reshape(B, S, G, HPG, dk)

    g = jax.nn.sigmoid(gates).reshape(B, S, 3, G, HPG, 1)
    o = g[:, :, 0] * o_cmp + g[:, :, 1] * o_sel + g[:, :, 2] * o_win
    return o.reshape(B, S, H * dk)


def pool_mixer(u, w_pool, pool_scale):
    B, S, _ = u.shape
    uf = u.astype(jnp.float32).reshape(B, S, N_POOL_GROUPS, POOL_GROUP_DIM)
    c = jnp.cumsum(uf, axis=1)
    t = jnp.arange(S)
    means = []
    for gi, w in enumerate(POOL_WINDOWS):
        cg = c[:, :, gi]
        prev = jnp.pad(cg, ((0, 0), (w, 0), (0, 0)))[:, :S]
        cnt = jnp.minimum(t + 1, w).astype(jnp.float32)[None, :, None]
        means.append((cg - prev) / cnt)
    d = (jnp.stack(means, axis=2) - uf).astype(u.dtype)
    y = jnp.einsum('bsgc,gcd->bsgd', d, w_pool).reshape(B, S, D_POOL)
    return y * pool_scale


def setup_inputs(seed: int = 0) -> dict:
    key = jax.random.key(seed)
    ks = jax.random.split(key, 24)
    f32 = jnp.float32

    def nrm(k, shape, scale):
        return jax.random.normal(k, shape, f32) * scale

    def gain(k, shape):
        return 1.0 + 0.05 * jax.random.normal(k, shape, f32)

    L = DEPTH
    return {
        "x": jax.random.normal(ks[0], (BATCH, SEQ, D_MODEL), f32),
        "norm_ffn1": gain(ks[1], (L, D_MODEL)),
        "w_ffn1_gate": nrm(ks[2], (L, D_MODEL, D_FF), D_MODEL ** -0.5),
        "w_ffn1_up": nrm(ks[3], (L, D_MODEL, D_FF), D_MODEL ** -0.5),
        "w_ffn1_down": nrm(ks[4], (L, D_FF, D_MODEL), D_FF ** -0.5),
        "norm_mix": gain(ks[5], (L, D_MODEL)),
        "w_in": nrm(ks[6], (L, D_MODEL, D_IN), D_MODEL ** -0.5),
        "cmp_pos_k": nrm(ks[7], (L, CMP_BLOCK, HEAD_DIM), 0.1),
        "w_cmp_k1": nrm(ks[8], (L, CMP_BLOCK * HEAD_DIM, CMP_HIDDEN), (CMP_BLOCK * HEAD_DIM) ** -0.5),
        "w_cmp_k2": nrm(ks[9], (L, CMP_HIDDEN, HEAD_DIM), CMP_HIDDEN ** -0.5),
        "cmp_pos_v": nrm(ks[10], (L, CMP_BLOCK, HEAD_DIM), 0.1),
        "w_cmp_v1": nrm(ks[11], (L, CMP_BLOCK * HEAD_DIM, CMP_HIDDEN), (CMP_BLOCK * HEAD_DIM) ** -0.5),
        "w_cmp_v2": nrm(ks[12], (L, CMP_HIDDEN, HEAD_DIM), CMP_HIDDEN ** -0.5),
        "w_pool": nrm(ks[13], (L, N_POOL_GROUPS, POOL_GROUP_DIM, POOL_GROUP_DIM), POOL_GROUP_DIM ** -0.5),
        "pool_scale": gain(ks[14], (L, D_POOL)),
        "w_out": nrm(ks[15], (L, D_MIX, D_MODEL), D_MIX ** -0.5),
        "rel_table": nrm(ks[16], (REL_BUCKETS, N_ATT_HEADS), 0.5),
        "norm_ffn2": gain(ks[17], (L, D_MODEL)),
        "w_ffn2_gate": nrm(ks[18], (L, D_MODEL, D_FF), D_MODEL ** -0.5),
        "w_ffn2_up": nrm(ks[19], (L, D_MODEL, D_FF), D_MODEL ** -0.5),
        "w_ffn2_down": nrm(ks[20], (L, D_FF, D_MODEL), D_FF ** -0.5),
        "norm_final": gain(ks[21], (D_MODEL,)),
    }


def reference(x, norm_ffn1, w_ffn1_gate, w_ffn1_up, w_ffn1_down, norm_mix, w_in,
              cmp_pos_k, w_cmp_k1, w_cmp_k2, cmp_pos_v, w_cmp_v1, w_cmp_v2,
              w_pool, pool_scale, w_out, rel_table, norm_ffn2, w_ffn2_gate,
              w_ffn2_up, w_ffn2_down, norm_final):
    B, S, _ = x.shape
    splits = np.cumsum([D_ATT] + [D_KV] * 6 + [3 * N_ATT_HEADS]).tolist()
    for l in range(DEPTH):
        x = x + 0.5 * swiglu(rmsnorm(x, norm_ffn1[l]), w_ffn1_gate[l], w_ffn1_up[l], w_ffn1_down[l])
        h = rmsnorm(x, norm_mix[l])
        proj = h @ w_in[l]
        q, kc, vc, ksl, vsl, kwn, vwn, gates, u = jnp.split(proj, splits, axis=-1)
        q = q.reshape(B, S, N_KV_GROUPS, HEADS_PER_GROUP, HEAD_DIM) * (HEAD_DIM ** -0.5)
        kv = lambda t: t.reshape(B, S, N_KV_GROUPS, HEAD_DIM)
        y_att = nsa_attention(q, kv(kc), kv(vc), kv(ksl), kv(vsl), kv(kwn), kv(vwn), gates,
                              cmp_pos_k[l], w_cmp_k1[l], w_cmp_k2[l],
                              cmp_pos_v[l], w_cmp_v1[l], w_cmp_v2[l], rel_table)
        y_pool = pool_mixer(u, w_pool[l], pool_scale[l])
        x = x + jnp.concatenate([y_att, y_pool], axis=-1) @ w_out[l]
        x = x + 0.5 * swiglu(rmsnorm(x, norm_ffn2[l]), w_ffn2_gate[l], w_ffn2_up[l], w_ffn2_down[l])
    return rmsnorm(x, norm_final)
```

```cpp
#include <hip/hip_runtime.h>
#include <cstdio>
#include <cstdint>

#ifndef MK_N_LAUNCHES
#define MK_N_LAUNCHES 1
#endif
#ifndef PROBE_DUP
#define PROBE_DUP -1
#endif

#define LAS __attribute__((address_space(3)))
#define GAS __attribute__((address_space(1)))
typedef unsigned short bf16_t;
typedef short bf16x8 __attribute__((ext_vector_type(8)));
typedef short s16x4 __attribute__((ext_vector_type(4)));
typedef float f32x4 __attribute__((ext_vector_type(4)));
typedef float f32x16 __attribute__((ext_vector_type(16)));
typedef unsigned u32x4 __attribute__((ext_vector_type(4)));
typedef unsigned u32x2 __attribute__((ext_vector_type(2)));
typedef int i32x4 __attribute__((ext_vector_type(4)));
typedef unsigned long long u64;

constexpr int BATCH = 4, SEQ = 2048, DM = 4096, FF = 11008, NGU = 2 * FF, M = BATCH * SEQ;
constexpr int NH = 16, NG = 4, HD = 128, DATT = 2048, DKV = 512, DPOOL = 2048;
__host__ __device__ __forceinline__ size_t blk_off(int r, int k, int KT) { return ((size_t)((r >> 8) * KT + (k >> 6)) * 256 + (size_t)(r & 255)) * 64 + (size_t)(k & 63); }
constexpr int KT4 = DM / 64, KTF = FF / 64, KTP = 512 / 64;
__host__ __device__ __forceinline__ size_t blk8_off(int r, int k, int KT8_) { return ((size_t)((r >> 8) * KT8_ + (k >> 7)) * 256 + (size_t)(r & 255)) * 128 + (size_t)(k & 127); }
constexpr int KT8 = DM / 128;
constexpr int NIN = 7216, NINP = 7424;
constexpr float EPS = 1e-6f;
constexpr float LOG2E = 1.4426950408889634f;
constexpr float QSCALE = 0.08838834764831845f * LOG2E;

__device__ __forceinline__ unsigned cvt_pk_bf16(float lo, float hi) { unsigned r; asm volatile("v_cvt_pk_bf16_f32 %0, %1, %2" : "=v"(r) : "v"(lo), "v"(hi)); return r; }
__device__ __forceinline__ float rs_from_acc(u64 a) { return __builtin_amdgcn_rsqf((float)a * (1.0f / (4294967296.0f * 4096.0f)) + EPS); }

namespace pg8 {
constexpr int BM = 256, BK = 64, HALF = 128, HTB = HALF * BK * 2, STAGE_BYTES = 8 * HTB, NXCD = 8, WGM = 4;
__host__ __device__ __forceinline__ int lds_byte(int r, int c) { const int st = (r >> 4) * 2 + (c >> 5), rr = r & 15, cc = c & 31, ob = rr * 64 + cc * 2; return st * 1024 + (ob ^ (((ob >> 9) & 1) << 5)); }
__host__ __device__ __forceinline__ void stage_rc(int b, int& R, int& C) { const int st = b / 1024, sb = b % 1024, swz = sb ^ (((sb >> 9) & 1) << 5); R = (st >> 1) * 16 + swz / 64; C = (st & 1) * 32 + (swz % 64) / 2; }
__host__ __device__ __forceinline__ int perm32(int rho) { const int n = rho >> 4, i = rho & 15; return 8 * (i >> 2) + 4 * n + (i & 3); }

struct Unit { int pm, pn, g; };
struct Gemm { const void* A; const void* Bt; int K, esz; };

struct StaticOrder {
    int nM, nN, nwg, G, c;
    __device__ void init(int M_, int N_, int G_, int c_) { nM = M_ / BM; nN = N_ / BM; nwg = nM * nN; G = G_; c = c_; }
    __device__ bool next(int i, Unit& u) const {
        const long L = (long)i * G + c; if (L >= nwg) return false;
        int wgid = (int)L; { const int q = nwg / NXCD, r = nwg % NXCD, xcd = wgid % NXCD, off = wgid / NXCD; wgid = (xcd < r ? xcd * (q + 1) : r * (q + 1) + (xcd - r) * q) + off; }
        const int nig = WGM * nN, gid = wgid / nig, fm = gid * WGM, gsz = (nM - fm) < WGM ? (nM - fm) : WGM;
        u.pm = fm + ((wgid % nig) % gsz); u.pn = (wgid % nig) / gsz; u.g = 0; return true;
    }
    __device__ __forceinline__ size_t aoff(const Unit& u, const Gemm& g) const { return (size_t)u.pm * BM * g.K * g.esz; }
    __device__ __forceinline__ size_t boff(const Unit& u, const Gemm& g) const { return (size_t)u.pn * BM * g.K * g.esz; }
};
struct PoolOrder {
    int G, c;
    __device__ bool next(int i, Unit& u) const { const int L = i * G + c; if (L >= 256) return false; u.g = L >> 6; const int r = L & 63; u.pm = r >> 1; u.pn = r & 1; return true; }
    __device__ __forceinline__ size_t aoff(const Unit& u, const Gemm& g) const { return (size_t)(u.g * 32 + u.pm) * BM * g.K * g.esz; }
    __device__ __forceinline__ size_t boff(const Unit& u, const Gemm& g) const { return (size_t)(u.g * 2 + u.pn) * BM * g.K * g.esz; }
};

template <class Epi, class Sched, bool I8 = false>
__device__ __forceinline__ void gemm_phase(LAS unsigned char* lds, const Gemm g, const Sched& S, const Epi& E) {
    const int tid = threadIdx.x, wid = __builtin_amdgcn_readfirstlane(tid >> 6), lane = tid & 63, wr = wid >> 2, wc = wid & 3, fr = lane & 15, fq = lane >> 4;
    const int nt = g.K * g.esz / (BK * 2);
    unsigned voffA[2], voffB[2];
#pragma unroll
    for (int i = 0; i < 2; ++i) { int R, C; stage_rc(tid * 16 + i * 8192, R, C); const int Rb = Epi::PERM ? ((R & ~31) + perm32(R & 31)) : R;
        voffA[i] = (unsigned)(R * 64 + C) * 2u; voffB[i] = (unsigned)(Rb * 64 + C) * 2u; }
    const size_t kstep = (size_t)(BM * BK * 2);
    const size_t hstepA = (size_t)HALF * BK * 2, hstepB = (size_t)HALF * BK * 2;
    const unsigned ldsw = (unsigned)wid * 1024u;
    const int aoff = lds_byte(wr * 64 + fr, fq * 8), boff = lds_byte(wc * 32 + fr, fq * 8);
#define PG8_SA(b, h) (((b) * 2 + (h)) * HTB)
#define PG8_SB(b, h) ((4 + (b) * 2 + (h)) * HTB)
#define PG8_STAGE(bufoff, gbase, voff) do { _Pragma("unroll") for (int _i = 0; _i < 2; ++_i) \
        __builtin_amdgcn_global_load_lds((const unsigned*)((const char*)(gbase) + (voff)[_i]), (LAS unsigned*)(lds + (bufoff) + ldsw + _i * 8192), 16, 0, 0); } while (0)
#define PG8_LDA(dst, b, h) do { _Pragma("unroll") for (int m = 0; m < 4; ++m) _Pragma("unroll") for (int k = 0; k < 2; ++k) dst[m][k] = *(const LAS bf16x8*)(lds + PG8_SA(b, h) + aoff + m * 2048 + k * 1024); } while (0)
#define PG8_LDB(dst, b, h) do { _Pragma("unroll") for (int n = 0; n < 2; ++n) _Pragma("unroll") for (int k = 0; k < 2; ++k) dst[n][k] = *(const LAS bf16x8*)(lds + PG8_SB(b, h) + boff + n * 2048 + k * 1024); } while (0)
#define PG8_MMA(ai, bj, At, Bt) do { __builtin_amdgcn_s_setprio(1); _Pragma("unroll") for (int m = 0; m < 4; ++m) _Pragma("unroll") for (int n = 0; n < 2; ++n) _Pragma("unroll") for (int k = 0; k < 2; ++k) { \
        if constexpr (I8) acc[ai][bj][m][n] = __builtin_bit_cast(acc_t, __builtin_amdgcn_mfma_i32_16x16x64_i8(__builtin_bit_cast(i32x4, Bt[n][k]), __builtin_bit_cast(i32x4, At[m][k]), __builtin_bit_cast(i32x4, acc[ai][bj][m][n]), 0, 0, 0)); \
        else acc[ai][bj][m][n] = __builtin_bit_cast(acc_t, __builtin_amdgcn_mfma_f32_16x16x32_bf16(Bt[n][k], At[m][k], __builtin_bit_cast(f32x4, acc[ai][bj][m][n]), 0, 0, 0)); } __builtin_amdgcn_s_setprio(0); } while (0)
#define PG8_WAIT_V(n) asm volatile("s_waitcnt vmcnt(" #n ")" ::: "memory")
#define PG8_WAIT_L(n) asm volatile("s_waitcnt lgkmcnt(" #n ")" ::: "memory")
#define PG8_BAR __builtin_amdgcn_s_barrier()
#define PG8_SCHED __builtin_amdgcn_sched_barrier(0)
    Unit cur, nxt; int ui = 0;
    if (!S.next(0, cur)) return;
    typedef typename Epi::acc_t acc_t;
    acc_t acc[2][2][4][2];
#pragma unroll
    for (int a = 0; a < 2; ++a)
#pragma unroll
        for (int b = 0; b < 2; ++b)
#pragma unroll
            for (int m = 0; m < 4; ++m)
#pragma unroll
                for (int n = 0; n < 2; ++n) acc[a][b][m][n] = acc_t{};
    bf16x8 At[4][2], B0[2][2], B1[2][2];
    const char* cA = (const char*)g.A + S.aoff(cur, g); const char* cB = (const char*)g.Bt + S.boff(cur, g);
    PG8_STAGE(PG8_SB(0, 0), cB, voffB); PG8_STAGE(PG8_SB(0, 1), cB + hstepB, voffB); PG8_STAGE(PG8_SA(0, 0), cA, voffA); PG8_STAGE(PG8_SA(0, 1), cA + hstepA, voffA);
    if (wr == 1) PG8_BAR;
    PG8_WAIT_V(2); PG8_BAR;
    PG8_STAGE(PG8_SB(1, 0), cB + kstep, voffB); PG8_STAGE(PG8_SA(1, 0), cA + kstep, voffA); PG8_STAGE(PG8_SB(1, 1), cB + hstepB + kstep, voffB);
    PG8_WAIT_V(6); PG8_BAR;
    for (;;) {
        const bool has_next = S.next(ui + 1, nxt);
        const char* nA = has_next ? (const char*)g.A + S.aoff(nxt, g) : cA; const char* nB = has_next ? (const char*)g.Bt + S.boff(nxt, g) : cB;
        for (int t = 0; t < nt; t += 2) {
            const bool last = (t == nt - 2);
            const char* a1 = cA + (size_t)(t + 1) * kstep;
            const char* a2 = last ? nA : cA + (size_t)(t + 2) * kstep; const char* b2 = last ? nB : cB + (size_t)(t + 2) * kstep;
            const char* a3 = a2 + kstep; const char* b3 = b2 + kstep;
            PG8_LDB(B0, 0, 0); PG8_LDB(B1, 0, 1); PG8_SCHED; PG8_LDA(At, 0, 0); PG8_STAGE(PG8_SA(1, 1), a1 + hstepA, voffA);
            PG8_WAIT_V(8); PG8_WAIT_L(0); PG8_BAR; PG8_MMA(0, 0, At, B0); PG8_MMA(0, 1, At, B1); PG8_BAR; PG8_SCHED;
            PG8_LDA(At, 0, 1); PG8_STAGE(PG8_SB(0, 0), b2, voffB); PG8_STAGE(PG8_SB(0, 1), b2 + hstepB, voffB); PG8_STAGE(PG8_SA(0, 0), a2, voffA);
            PG8_WAIT_V(8); PG8_WAIT_L(0); PG8_BAR; PG8_MMA(1, 0, At, B0); PG8_MMA(1, 1, At, B1); PG8_BAR; PG8_SCHED;
            PG8_LDB(B0, 1, 0); PG8_LDB(B1, 1, 1); PG8_SCHED; PG8_LDA(At, 1, 0); PG8_STAGE(PG8_SA(0, 1), a2 + hstepA, voffA);
            PG8_WAIT_V(8); PG8_WAIT_L(0); PG8_BAR; PG8_MMA(0, 0, At, B0); PG8_MMA(0, 1, At, B1); PG8_BAR; PG8_SCHED;
            PG8_LDA(At, 1, 1); PG8_STAGE(PG8_SB(1, 0), b3, voffB); PG8_STAGE(PG8_SB(1, 1), b3 + hstepB, voffB); PG8_STAGE(PG8_SA(1, 0), a3, voffA);
            PG8_WAIT_V(8); PG8_WAIT_L(0); PG8_BAR; PG8_MMA(1, 0, At, B0); PG8_MMA(1, 1, At, B1); PG8_BAR; PG8_SCHED;
        }
        if (wr == 0) PG8_BAR;
        E(acc, cur, wr, wc, fr, fq);
        if (!has_next) break;
#pragma unroll
        for (int a = 0; a < 2; ++a)
#pragma unroll
            for (int b = 0; b < 2; ++b)
#pragma unroll
                for (int m = 0; m < 4; ++m)
#pragma unroll
                    for (int n = 0; n < 2; ++n) acc[a][b][m][n] = acc_t{};
        cur = nxt; cA = nA; cB = nB; ++ui;
        if (wr == 1) PG8_BAR;
    }
    PG8_WAIT_V(0);
    PG8_BAR;
#undef PG8_SA
#undef PG8_SB
#undef PG8_STAGE
#undef PG8_LDA
#undef PG8_LDB
#undef PG8_MMA
#undef PG8_WAIT_V
#undef PG8_WAIT_L
#undef PG8_BAR
#undef PG8_SCHED
}
}

__device__ __forceinline__ float silu_mul(float g, float u) { return g * u * __builtin_amdgcn_rcpf(1.0f + __builtin_amdgcn_exp2f(-g * LOG2E)); }

template <bool R64> struct EpiSwiGLU {
    static constexpr bool PERM = true; typedef f32x4 acc_t;
    bf16_t* O; const void* rs;
    __device__ __forceinline__ void operator()(const f32x4 (&acc)[2][2][4][2], const pg8::Unit& u, int wr, int wc, int fr, int fq) const {
        const int row0 = u.pm * 256 + wr * 64 + fr, col0 = u.pn * 128 + wc * 32 + 8 * fq;
        float rr[2][4];
#pragma unroll
        for (int ai = 0; ai < 2; ++ai)
#pragma unroll
            for (int m = 0; m < 4; ++m) { const int row = row0 + ai * 128 + m * 16; rr[ai][m] = R64 ? rs_from_acc(((const u64*)rs)[row]) : ((const float*)rs)[row]; }
#pragma unroll
        for (int ai = 0; ai < 2; ++ai)
#pragma unroll
            for (int m = 0; m < 4; ++m) {
                const int row = row0 + ai * 128 + m * 16;
                const float r = rr[ai][m];
                const f32x4 g0 = acc[ai][0][m][0] * r, g1 = acc[ai][0][m][1] * r, u0 = acc[ai][1][m][0] * r, u1 = acc[ai][1][m][1] * r;
                u32x4 w;
                w.x = cvt_pk_bf16(silu_mul(g0[0], u0[0]), silu_mul(g0[1], u0[1])); w.y = cvt_pk_bf16(silu_mul(g0[2], u0[2]), silu_mul(g0[3], u0[3]));
                w.z = cvt_pk_bf16(silu_mul(g1[0], u1[0]), silu_mul(g1[1], u1[1])); w.w = cvt_pk_bf16(silu_mul(g1[2], u1[2]), silu_mul(g1[3], u1[3]));
                *(u32x4*)(O + blk_off(row, col0, KTF)) = w;
            }
    }
};
__device__ __forceinline__ float bfly8(float x, bool up) { const float p = __uint_as_float(__builtin_amdgcn_update_dpp(0u, __float_as_uint(x), 0x128, 0xf, 0xf, false)); return up ? p - x : x + p; }
__device__ __forceinline__ float bfly16(float x, bool up) { const auto r = __builtin_amdgcn_permlane16_swap(__float_as_uint(x), __float_as_uint(x), false, false); const float a = __uint_as_float(r[0]), b = __uint_as_float(r[1]); return up ? a - b : a + b; }
__device__ __forceinline__ float bfly32(float x, bool up) { const auto r = __builtin_amdgcn_permlane32_swap(__float_as_uint(x), __float_as_uint(x), false, false); const float a = __uint_as_float(r[0]), b = __uint_as_float(r[1]); return up ? a - b : a + b; }
template <bool ROT>
struct EpiSwiGLUQ {
    static constexpr bool PERM = true; typedef i32x4 acc_t;
    bf16_t* O; const float* ra; const float* sb; unsigned* rmax;
    __device__ __forceinline__ void operator()(const i32x4 (&acc)[2][2][4][2], const pg8::Unit& u, int wr, int wc, int fr, int fq) const {
        const int row0 = u.pm * 256 + wr * 64 + fr, col0 = u.pn * 128 + wc * 32 + 8 * fq, ch0 = u.pn * 256 + wc * 32 + 8 * fq;
        const f32x4 sg0 = *(const f32x4*)(sb + ch0), sg1 = *(const f32x4*)(sb + ch0 + 4), su0 = *(const f32x4*)(sb + ch0 + 128), su1 = *(const f32x4*)(sb + ch0 + 132);
        float rr[2][4];
#pragma unroll
        for (int ai = 0; ai < 2; ++ai)
#pragma unroll
            for (int m = 0; m < 4; ++m) rr[ai][m] = ra[row0 + ai * 128 + m * 16];
#pragma unroll
        for (int ai = 0; ai < 2; ++ai)
#pragma unroll
            for (int m = 0; m < 4; ++m) {
                const int row = row0 + ai * 128 + m * 16; const float r = rr[ai][m];
                f32x4 g0, g1, u0, u1;
#pragma unroll
                for (int e = 0; e < 4; ++e) { g0[e] = (float)acc[ai][0][m][0][e] * r * sg0[e]; g1[e] = (float)acc[ai][0][m][1][e] * r * sg1[e]; u0[e] = (float)acc[ai][1][m][0][e] * r * su0[e]; u1[e] = (float)acc[ai][1][m][1][e] * r * su1[e]; }
                float h0 = silu_mul(g0[0], u0[0]), h1 = silu_mul(g0[1], u0[1]), h2 = silu_mul(g0[2], u0[2]), h3 = silu_mul(g0[3], u0[3]);
                float h4 = silu_mul(g1[0], u1[0]), h5 = silu_mul(g1[1], u1[1]), h6 = silu_mul(g1[2], u1[2]), h7 = silu_mul(g1[3], u1[3]);
                if (ROT) {
#define FW_BF(a, b) { const float t_ = a; a = t_ + b; b = t_ - b; }
                    FW_BF(h0, h1) FW_BF(h2, h3) FW_BF(h4, h5) FW_BF(h6, h7)
                    FW_BF(h0, h2) FW_BF(h1, h3) FW_BF(h4, h6) FW_BF(h5, h7)
                    FW_BF(h0, h4) FW_BF(h1, h5) FW_BF(h2, h6) FW_BF(h3, h7)
#undef FW_BF
#define FW_X(h, L, sgn) { h = (L == 16) ? bfly16(h, sgn) : bfly32(h, sgn); }
                    { const bool s16 = (fq & 1) != 0, s32 = (fq & 2) != 0;
                      FW_X(h0, 16, s16) FW_X(h1, 16, s16) FW_X(h2, 16, s16) FW_X(h3, 16, s16) FW_X(h4, 16, s16) FW_X(h5, 16, s16) FW_X(h6, 16, s16) FW_X(h7, 16, s16)
                      FW_X(h0, 32, s32) FW_X(h1, 32, s32) FW_X(h2, 32, s32) FW_X(h3, 32, s32) FW_X(h4, 32, s32) FW_X(h5, 32, s32) FW_X(h6, 32, s32) FW_X(h7, 32, s32) }
#undef FW_X
                    const float sc = 0.17677669529663687f;
                    h0 *= sc; h1 *= sc; h2 *= sc; h3 *= sc; h4 *= sc; h5 *= sc; h6 *= sc; h7 *= sc;
                }
                u32x4 w;
                w.x = cvt_pk_bf16(h0, h1); w.y = cvt_pk_bf16(h2, h3); w.z = cvt_pk_bf16(h4, h5); w.w = cvt_pk_bf16(h6, h7);
                *(u32x4*)(O + blk_off(row, col0, KTF)) = w;
                if (rmax) {
                    unsigned mb = 0u;
#pragma unroll
                    for (int e = 0; e < 4; ++e) { const unsigned x = w[e]; const unsigned lo = (x << 16) & 0x7fff0000u, hi2 = x & 0x7fff0000u; mb = mb > lo ? mb : lo; mb = mb > hi2 ? mb : hi2; }
                    unsigned o1 = __shfl_xor(mb, 16); mb = mb > o1 ? mb : o1; o1 = __shfl_xor(mb, 32); mb = mb > o1 ? mb : o1;
                    if (fq == 0) atomicMax(rmax + row, mb);
                }
            }
    }
};
struct EpiResidQ {
    static constexpr bool PERM = true; typedef i32x4 acc_t;
    const float* res; float* out; u64* racc; const float* sh; const float* sbn; float alpha; bf16_t* ob;
    __device__ __forceinline__ void operator()(const i32x4 (&acc)[2][2][4][2], const pg8::Unit& u, int wr, int wc, int fr, int fq) const {
        int row0 = u.pm * 256 + wr * 64 + fr, col0 = u.pn * 256 + wc * 32 + 8 * fq;
        asm volatile("" : "+v"(row0), "+v"(col0));
        f32x4 s0[2], s1[2];
#pragma unroll
        for (int bj = 0; bj < 2; ++bj) { s0[bj] = *(const f32x4*)(sbn + col0 + bj * 128); s1[bj] = *(const f32x4*)(sbn + col0 + bj * 128 + 4); }
#pragma unroll
        for (int ai = 0; ai < 2; ++ai)
#pragma unroll
            for (int mh = 0; mh < 2; ++mh) {
                f32x4 pa[2][2], pb[2][2]; float rs[2];
#pragma unroll
                for (int mm = 0; mm < 2; ++mm) { const int row = row0 + ai * 128 + (2 * mh + mm) * 16; rs[mm] = sh[row] * alpha;
#pragma unroll
                    for (int bj = 0; bj < 2; ++bj) { const size_t off = (size_t)row * DM + col0 + bj * 128; pa[mm][bj] = *(const f32x4*)(res + off); pb[mm][bj] = *(const f32x4*)(res + off + 4); } }
#pragma unroll
                for (int mm = 0; mm < 2; ++mm) {
                    const int m = 2 * mh + mm, row = row0 + ai * 128 + m * 16; float ss = 0.f;
#pragma unroll
                    for (int bj = 0; bj < 2; ++bj) {
                        const size_t off = (size_t)row * DM + col0 + bj * 128; f32x4 v0, v1;
#pragma unroll
                        for (int e = 0; e < 4; ++e) { v0[e] = pa[mm][bj][e] + (float)acc[ai][bj][m][0][e] * rs[mm] * s0[bj][e]; v1[e] = pb[mm][bj][e] + (float)acc[ai][bj][m][1][e] * rs[mm] * s1[bj][e]; }
                        if (out) { *(f32x4*)(out + off) = v0; *(f32x4*)(out + off + 4) = v1; }
                        if (ob) { u32x4 w; w.x = cvt_pk_bf16(v0[0], v0[1]); w.y = cvt_pk_bf16(v0[2], v0[3]); w.z = cvt_pk_bf16(v1[0], v1[1]); w.w = cvt_pk_bf16(v1[2], v1[3]); *(u32x4*)(ob + blk_off(row, col0 + bj * 128, KT4)) = w; }
                        ss += (v0[0] * v0[0] + v0[1] * v0[1]) + (v0[2] * v0[2] + v0[3] * v0[3]) + (v1[0] * v1[0] + v1[1] * v1[1]) + (v1[2] * v1[2] + v1[3] * v1[3]);
                    }
                    ss += __shfl_xor(ss, 16); ss += __shfl_xor(ss, 32);
                    if (fq == 0 && racc) atomicAdd(racc + row, (u64)(ss * 4294967296.0f));
                }
            }
    }
};
struct EpiResid {
    static constexpr bool PERM = true; typedef f32x4 acc_t;
    const float* res; float* out; bf16_t* ob; u64* racc; float alpha;
    __device__ __forceinline__ void operator()(const f32x4 (&acc)[2][2][4][2], const pg8::Unit& u, int wr, int wc, int fr, int fq) const {
        const int row0 = u.pm * 256 + wr * 64 + fr, col0 = u.pn * 256 + wc * 32 + 8 * fq;
#pragma unroll
        for (int ai = 0; ai < 2; ++ai) {
            f32x4 pa[4][2], pb[4][2];
#pragma unroll
            for (int m = 0; m < 4; ++m)
#pragma unroll
                for (int bj = 0; bj < 2; ++bj) { const size_t off = (size_t)(row0 + ai * 128 + m * 16) * DM + col0 + bj * 128; pa[m][bj] = *(const f32x4*)(res + off); pb[m][bj] = *(const f32x4*)(res + off + 4); }
#pragma unroll
            for (int m = 0; m < 4; ++m) {
                const int row = row0 + ai * 128 + m * 16; float ss = 0.f;
#pragma unroll
                for (int bj = 0; bj < 2; ++bj) {
                    const size_t off = (size_t)row * DM + col0 + bj * 128;
                    const f32x4 v0 = pa[m][bj] + acc[ai][bj][m][0] * alpha, v1 = pb[m][bj] + acc[ai][bj][m][1] * alpha;
                    *(f32x4*)(out + off) = v0; *(f32x4*)(out + off + 4) = v1;
                    if (ob) { u32x4 w; w.x = cvt_pk_bf16(v0[0], v0[1]); w.y = cvt_pk_bf16(v0[2], v0[3]); w.z = cvt_pk_bf16(v1[0], v1[1]); w.w = cvt_pk_bf16(v1[2], v1[3]); *(u32x4*)(ob + blk_off(row, col0 + bj * 128, KT4)) = w; }
                    ss += (v0[0] * v0[0] + v0[1] * v0[1]) + (v0[2] * v0[2] + v0[3] * v0[3]) + (v1[0] * v1[0] + v1[1] * v1[1]) + (v1[2] * v1[2] + v1[3] * v1[3]);
                }
                ss += __shfl_xor(ss, 16); ss += __shfl_xor(ss, 32);
                if (fq == 0 && racc) atomicAdd(racc + row, (u64)(ss * 4294967296.0f));
            }
        }
    }
};
struct EpiWin {
    static constexpr bool PERM = true; typedef f32x4 acc_t;
    bf16_t* qb; bf16_t* kvb; float* ub; float* gb; const u64* racc; size_t kv_stride;
    __device__ __forceinline__ void operator()(const f32x4 (&acc)[2][2][4][2], const pg8::Unit& u, int wr, int wc, int fr, int fq) const {
        const int row0 = u.pm * 256 + wr * 64 + fr, pn = u.pn, cw = wc * 32 + 8 * fq;
        float rr[2][4];
#pragma unroll
        for (int ai = 0; ai < 2; ++ai)
#pragma unroll
            for (int m = 0; m < 4; ++m) rr[ai][m] = rs_from_acc(racc[row0 + ai * 128 + m * 16]);
#pragma unroll
        for (int ai = 0; ai < 2; ++ai)
#pragma unroll
            for (int m = 0; m < 4; ++m) {
                const int row = row0 + ai * 128 + m * 16, b = row >> 11, s = row & 2047;
                const float r = rr[ai][m];
#pragma unroll
                for (int bj = 0; bj < 2; ++bj) {
                    f32x4 v0 = acc[ai][bj][m][0] * r, v1 = acc[ai][bj][m][1] * r;
                    if (pn < 8) {
                        v0 = v0 * QSCALE; v1 = v1 * QSCALE; const int h = 2 * pn + bj;
                        u32x4 w; w.x = cvt_pk_bf16(v0[0], v0[1]); w.y = cvt_pk_bf16(v0[2], v0[3]); w.z = cvt_pk_bf16(v1[0], v1[1]); w.w = cvt_pk_bf16(v1[2], v1[3]);
                        *(u32x4*)(qb + ((size_t)(b * NH + h) * SEQ + s) * HD + cw) = w;
                    } else if (pn < 20) {
                        const int ti = (pn - 8) >> 1, gg = ((pn - 8) & 1) * 2 + bj;
                        u32x4 w; w.x = cvt_pk_bf16(v0[0], v0[1]); w.y = cvt_pk_bf16(v0[2], v0[3]); w.z = cvt_pk_bf16(v1[0], v1[1]); w.w = cvt_pk_bf16(v1[2], v1[3]);
                        *(u32x4*)(kvb + (size_t)ti * kv_stride + ((size_t)(b * NG + gg) * SEQ + s) * HD + cw) = w;
                    } else if (pn < 28) {
                        float* p = ub + (size_t)row * DPOOL + (pn - 20) * 256 + bj * 128 + cw;
                        *(f32x4*)p = v0; *(f32x4*)(p + 4) = v1;
                    } else {
                        if (bj == 0 && cw < 48) {
                            float* p = gb + (size_t)row * 48 + cw; f32x4 s0, s1;
#pragma unroll
                            for (int e = 0; e < 4; ++e) { s0[e] = __builtin_amdgcn_rcpf(1.0f + __builtin_amdgcn_exp2f(-v0[e] * LOG2E)); s1[e] = __builtin_amdgcn_rcpf(1.0f + __builtin_amdgcn_exp2f(-v1[e] * LOG2E)); }
                            *(f32x4*)p = s0; *(f32x4*)(p + 4) = s1;
                        }
                    }
                }
            }
    }
};
struct EpiPool {
    static constexpr bool PERM = true; typedef f32x4 acc_t;
    bf16_t* ymix; const float* pscale;
    __device__ __forceinline__ void operator()(const f32x4 (&acc)[2][2][4][2], const pg8::Unit& u, int wr, int wc, int fr, int fq) const {
        const int row0 = u.pm * 256 + wr * 64 + fr, colb = u.g * 512 + u.pn * 256 + wc * 32 + 8 * fq;
#pragma unroll
        for (int bj = 0; bj < 2; ++bj) {
            const int col = colb + bj * 128; const f32x4 s0 = *(const f32x4*)(pscale + col), s1 = *(const f32x4*)(pscale + col + 4);
#pragma unroll
            for (int ai = 0; ai < 2; ++ai)
#pragma unroll
                for (int m = 0; m < 4; ++m) {
                    const int row = row0 + ai * 128 + m * 16; const f32x4 v0 = acc[ai][bj][m][0] * s0, v1 = acc[ai][bj][m][1] * s1;
                    u32x4 w; w.x = cvt_pk_bf16(v0[0], v0[1]); w.y = cvt_pk_bf16(v0[2], v0[3]); w.z = cvt_pk_bf16(v1[0], v1[1]); w.w = cvt_pk_bf16(v1[2], v1[3]);
                    *(u32x4*)(ymix + blk_off(row, DATT + col, KT4)) = w;
                }
        }
    }
};

constexpr size_t MiB = 1u << 20;
constexpr size_t WS_CTL = 0, CTL_ZERO_BYTES = 2 * MiB;
constexpr size_t WS_WGU1 = 2 * MiB, WS_WD1 = WS_WGU1 + 172 * MiB, WS_WIN = WS_WD1 + 86 * MiB, WS_WOUT = WS_WIN + 58 * MiB;
constexpr size_t WS_WGU2 = WS_WOUT + 32 * MiB, WS_WD2 = WS_WGU2 + 172 * MiB, WS_SMALL = WS_WD2 + 86 * MiB;
constexpr size_t SM_WPOOL = 0, SM_WCK1 = 3 * MiB, SM_WCV1 = 4 * MiB, SM_WCK2 = 5 * MiB, SM_WCV2 = 5 * MiB + 65536, SM_PBP = 5 * MiB + 131072, SM_R0 = 5 * MiB + 131072 + 262144;
constexpr size_t WS_HID = WS_SMALL + 7 * MiB, WS_ACTB = WS_HID + 172 * MiB, WS_Q = WS_ACTB + 64 * MiB, WS_KV = WS_Q + 32 * MiB;
constexpr size_t KV_STRIDE_B = 8 * MiB + 65536;
constexpr size_t WS_KCMP = WS_KV + 6 * KV_STRIDE_B, WS_VCMP = WS_KCMP + 1 * MiB, WS_GATES = WS_VCMP + 1 * MiB, WS_U = WS_GATES + 2 * MiB;
constexpr size_t WS_DPOOL = WS_U + 64 * MiB, WS_YMIX = WS_DPOOL + 32 * MiB, WS_END = WS_YMIX + 64 * MiB;
constexpr size_t WS_XQ = WS_END, WS_END2 = WS_XQ + 32 * MiB;
constexpr size_t SM_SB1 = 6 * MiB, SM_SB2 = 6 * MiB + 131072, SM_RA0 = 6 * MiB + 262144, SM_RA2 = 6 * MiB + 327680;
constexpr size_t WS_HIDQ = WS_END2, WS_END3 = WS_HIDQ + 86 * MiB;
constexpr int ROT1 = 2, ROT2 = 2;
constexpr size_t SM_SB4 = 6 * MiB + 458752;
constexpr size_t SM_SB3 = 6 * MiB + 393216, SM_SH = 6 * MiB + 425984;
constexpr size_t CTL_PBSUM = 1024 * 1024;
constexpr size_t CTL_RMAX = 768 * 1024;
constexpr size_t CTL_CMAX = 512 * 1024;
constexpr int CW_BAR = 4096;
constexpr size_t CTL_RACC = 256 * 1024;
static_assert(22016ull * 4096 * 2 == 172 * MiB && 4096ull * 11008 * 2 == 86 * MiB && 7424ull * 4096 * 2 == 58 * MiB, "weight sizes");

constexpr int RING_BYTES = 131072, LDS_BYTES = 163840, CTRL_OFF = LDS_BYTES - 2048, MISC_OFF = CTRL_OFF + 320, PTR_OFF = CTRL_OFF + 1024;
#define INP(k) ((const float*)(const GAS float*)(uintptr_t)(*(const LAS u64*)(F.lds + PTR_OFF + 8 * (k))))

#define XB_TMO      128
#define XB_XCNT(j)  (256  + 64 * (j))
#define XB_XSUB(j)  (1280 + 64 * (j))
#define XB_XGEN(j)  (2304 + 64 * (j))
#define XB_TOP      3328
#define XB_TOPGEN   3392
#define XCD_BAR_WORDS 3456
#define XB_SPIN_CAP (1u << 18)
__device__ __forceinline__ unsigned xb_ld(unsigned* p)              { return __hip_atomic_load(p, __ATOMIC_RELAXED, __HIP_MEMORY_SCOPE_AGENT); }
__device__ __forceinline__ unsigned xb_add(unsigned* p, unsigned v) { return __hip_atomic_fetch_add(p, v, __ATOMIC_RELAXED, __HIP_MEMORY_SCOPE_AGENT); }
__device__ __forceinline__ unsigned xb_xcc_id() { return (unsigned)__builtin_amdgcn_s_getreg((3 << 11) | 20) & 0xFu; }
#define XB_SPIN(cond, bar) do { unsigned _sp = 0; while (cond) { __builtin_amdgcn_s_sleep(1); \
    if ((++_sp & 255u) == 0u) { if (xb_ld(&(bar)[XB_TMO])) break; if (_sp > XB_SPIN_CAP) { atomicAdd(&(bar)[XB_TMO], 1u); break; } } } } while (0)
struct XcdBarrier { unsigned* bar; unsigned x; volatile LAS unsigned* st; };
__device__ __forceinline__ XcdBarrier xcd_barrier_post(unsigned* bar, volatile LAS unsigned* st) {
    XcdBarrier b; b.bar = bar; b.x = xb_xcc_id(); b.st = st;
    if (threadIdx.x == 0) (void)xb_add(&bar[XB_XCNT(b.x)], 1u);
    return b;
}
__device__ __forceinline__ void xcd_barrier_complete(unsigned* bar, unsigned x, unsigned& nloc, unsigned& nx) {
    const unsigned G = gridDim.x * gridDim.y * gridDim.z;
    unsigned sum, cnt, mine, sp = 0u;
    for (;;) {
        sum = 0u; cnt = 0u; mine = 0u;
#pragma unroll
        for (unsigned j = 0; j < 16; ++j) { const unsigned c = xb_ld(&bar[XB_XCNT(j)]); sum += c; cnt += (c > 0u) ? 1u : 0u; mine = (j == x) ? c : mine; }
        if (sum == G) break;
        __builtin_amdgcn_s_sleep(1);
        if ((++sp & 255u) == 0u) { if (xb_ld(&bar[XB_TMO])) break; if (sp > XB_SPIN_CAP) { atomicAdd(&bar[XB_TMO], 1u); break; } }
    }
    nloc = mine > 0u ? mine : 1u; nx = cnt > 0u ? cnt : 1u;
}
__device__ __forceinline__ void xcd_barrier(const XcdBarrier& b) {
    asm volatile("s_waitcnt vmcnt(0)" ::: "memory");
    __syncthreads();
    if (threadIdx.x == 0) {
        unsigned* bar = b.bar;
        __builtin_amdgcn_s_waitcnt(0);
        unsigned nloc = b.st[0], nx = b.st[1];
        if (nloc == 0u) { xcd_barrier_complete(bar, b.x, nloc, nx); b.st[0] = nloc; b.st[1] = nx; }
        const unsigned old = xb_add(&bar[XB_XSUB(b.x)], 1u);
        const unsigned gen = old / nloc;
        if (old + 1u == (gen + 1u) * nloc) {
            __builtin_amdgcn_fence(__ATOMIC_RELEASE, "agent");
            asm volatile("s_waitcnt vmcnt(0)" ::: "memory");
            const unsigned og = xb_add(&bar[XB_TOP], 1u);
            const unsigned tg = og / nx;
            if (og + 1u == (tg + 1u) * nx) xb_add(&bar[XB_TOPGEN], 1u);
            else XB_SPIN(xb_ld(&bar[XB_TOPGEN]) == tg, bar);
            __builtin_amdgcn_fence(__ATOMIC_ACQUIRE, "agent");
            xb_add(&bar[XB_XGEN(b.x)], 1u);
            asm volatile("s_waitcnt vmcnt(0)" ::: "memory");
        } else {
            XB_SPIN(xb_ld(&bar[XB_XGEN(b.x)]) == gen, bar);
            __builtin_amdgcn_fence(__ATOMIC_ACQUIRE, "agent");
            asm volatile("s_waitcnt vmcnt(0)" ::: "memory");
        }
    }
    __syncthreads();
}

struct Frame {
    LAS unsigned char* lds;
    int tid, wave, vcu, G;
    float* out; unsigned char* ws;
};
__device__ __forceinline__ unsigned f2bf(float f) { unsigned u = __builtin_bit_cast(unsigned, f); return (u + 0x7fffu + ((u >> 16) & 1u)) >> 16; }
__device__ __forceinline__ unsigned pk2(float lo, float hi) { return f2bf(lo) | (f2bf(hi) << 16); }
__device__ __forceinline__ float wave_sum(float v) {
#pragma unroll
    for (int o = 1; o < 64; o <<= 1) v += __shfl_xor(v, o);
    return v;
}
#define LDS_WAIT() asm volatile("s_waitcnt lgkmcnt(0)" ::: "memory")

__device__ __forceinline__ int win_map(int n) { return n < 5120 ? n : (n < 5168 ? 7168 + (n - 5120) : 5120 + (n - 5168)); }
struct P0Desc { const float* W; const float* gain; bf16_t* WT; int K, N, ldt, mode, bj, k0, n0; };
__device__ __forceinline__ void p0_load(f32x4 (&v)[16], float& gv, const P0Desc& d, int lane) {
    const int n = d.n0 + 4 * (lane & 15); const bool ok = n < d.N;
    gv = d.gain ? d.gain[d.k0 + lane] : 1.0f;
    const float* __restrict__ src = d.W + (size_t)(d.k0 + 2 * (lane >> 4)) * d.N + (ok ? n : 0);
#pragma unroll
    for (int i = 0; i < 16; ++i) v[i] = __builtin_nontemporal_load((const f32x4*)(src + (size_t)(8 * (i >> 1) + (i & 1)) * d.N));
}
__device__ __forceinline__ void p0_finish(f32x4 (&v)[16], float gv, const P0Desc& d, LAS unsigned* T, int lane) {
    const int kr = lane >> 4, nq = lane & 15;
#pragma unroll
    for (int j = 0; j < 8; ++j) {
        f32x4 a = v[2 * j], b = v[2 * j + 1];
        if (d.gain) { const float g0 = __shfl(gv, 8 * j + 2 * kr), g1 = __shfl(gv, 8 * j + 2 * kr + 1); a = a * g0; b = b * g1; }
#pragma unroll
        for (int e = 0; e < 4; ++e) T[(4 * nq + e) * 33 + 4 * j + kr] = cvt_pk_bf16(a[e], b[e]);
    }
    LDS_WAIT(); asm volatile("" ::: "memory");
    const int nl = lane >> 3, c = lane & 7;
#pragma unroll
    for (int g = 0; g < 8; ++g) {
        const int nloc = 8 * g + nl, n = d.n0 + nloc;
        const LAS unsigned* t = T + nloc * 33 + 4 * c;
        u32x4 o; o.x = t[0]; o.y = t[1]; o.z = t[2]; o.w = t[3];
        const int dr = d.mode == 0 ? n : (d.mode == 1 ? win_map(n) : 256 * (n >> 7) + 128 * d.bj + (n & 127));
        if (n < d.N) *(u32x4*)(d.WT + (d.ldt ? (size_t)dr * d.ldt + d.k0 + 8 * c : blk_off(dr, d.k0 + 8 * c, d.K >> 6))) = o;
    }
    LDS_WAIT(); asm volatile("" ::: "memory");
}
constexpr int P0_I_GU = 64 * 172, P0_I_D = 172 * 64, P0_I_IN = 64 * 113, P0_I_OUT = 64 * 64, P0_I_POOL = 8 * 8, P0_I_C1 = 64 * 2, P0_I_C2 = 2 * 2;
constexpr int P0_NITEMS = 4 * P0_I_GU + 2 * P0_I_D + P0_I_IN + P0_I_OUT + 4 * P0_I_POOL + 2 * P0_I_C1 + 2 * P0_I_C2;
__device__ __forceinline__ void p0_decode(Frame& F, int it, P0Desc& d) {
    unsigned char* ws = F.ws; int r = it; d.gain = nullptr; d.mode = 0; d.bj = 0;
    if (r < 4 * P0_I_GU) { const int q = r / P0_I_GU; r -= q * P0_I_GU; d.k0 = 64 * (r / 172); d.n0 = 64 * (r % 172); d.K = DM; d.ldt = 0; d.N = FF; d.mode = 2; d.bj = q & 1;
        d.W = q == 0 ? INP(2) : q == 1 ? INP(3) : q == 2 ? INP(18) : INP(19); d.gain = q < 2 ? INP(1) : INP(17); d.WT = (bf16_t*)(ws + (q < 2 ? WS_WGU1 : WS_WGU2)); return; }
    r -= 4 * P0_I_GU;
    if (r < 2 * P0_I_D) { const int q = r / P0_I_D; r -= q * P0_I_D; d.k0 = 64 * (r / 64); d.n0 = 64 * (r % 64); d.K = FF; d.ldt = 0; d.N = DM; d.W = q == 0 ? INP(4) : INP(20); d.WT = (bf16_t*)(ws + (q == 0 ? WS_WD1 : WS_WD2)); return; }
    r -= 2 * P0_I_D;
    if (r < P0_I_IN) { d.k0 = 64 * (r / 113); d.n0 = 64 * (r % 113); d.K = DM; d.ldt = 0; d.N = NIN; d.mode = 1; d.W = INP(6); d.gain = INP(5); d.WT = (bf16_t*)(ws + WS_WIN); return; }
    r -= P0_I_IN;
    if (r < P0_I_OUT) { d.k0 = 64 * (r / 64); d.n0 = 64 * (r % 64); d.K = DM; d.ldt = 0; d.N = DM; d.W = INP(15); d.WT = (bf16_t*)(ws + WS_WOUT); return; }
    r -= P0_I_OUT;
    if (r < 4 * P0_I_POOL) { const int q = r / P0_I_POOL; r -= q * P0_I_POOL; d.k0 = 64 * (r / 8); d.n0 = 64 * (r % 8); d.K = 512; d.ldt = 0; d.N = 512; d.W = INP(13) + (size_t)q * 512 * 512; d.WT = (bf16_t*)(ws + WS_SMALL + SM_WPOOL) + (size_t)q * 512 * 512; return; }
    r -= 4 * P0_I_POOL;
    if (r < 2 * P0_I_C1) { const int q = r / P0_I_C1; r -= q * P0_I_C1; d.k0 = 64 * (r / 2); d.n0 = 64 * (r % 2); d.K = 4096; d.ldt = 4096; d.N = 128; d.W = q == 0 ? INP(8) : INP(11); d.WT = (bf16_t*)(ws + WS_SMALL + (q == 0 ? SM_WCK1 : SM_WCV1)); return; }
    r -= 2 * P0_I_C1;
    { const int q = r / P0_I_C2; r -= q * P0_I_C2; d.k0 = 64 * (r / 2); d.n0 = 64 * (r % 2); d.K = 128; d.ldt = 128; d.N = 128; d.W = q == 0 ? INP(9) : INP(12); d.WT = (bf16_t*)(ws + WS_SMALL + (q == 0 ? SM_WCK2 : SM_WCV2)); }
}

__device__ __forceinline__ void p0_convert(Frame& F, int lo, int hi, int worker, int nworkers) {
    const int lane = (F.tid & 63), stride = nworkers * 8, first = lo + worker * 8 + F.wave;
    LAS unsigned* T = (LAS unsigned*)(F.lds + F.wave * 16384);
    if (first >= hi) return;
    const int n_my = (hi - first + stride - 1) / stride;
    f32x4 va[16], vb[16]; float ga, gb; P0Desc da, db;
    p0_decode(F, first, da); p0_load(va, ga, da, lane);
    for (int i = 0; i < n_my; i += 2) {
        { const int j = i + 1 < n_my ? i + 1 : n_my - 1; p0_decode(F, first + j * stride, db); p0_load(vb, gb, db, lane); }
        p0_finish(va, ga, da, T, lane);
        { const int j = i + 2 < n_my ? i + 2 : n_my - 1; p0_decode(F, first + j * stride, da); p0_load(va, ga, da, lane); }
        if (i + 1 < n_my) p0_finish(vb, gb, db, T, lane);
    }
}
constexpr int P0_R_GU2 = 2 * P0_I_GU, P0_R_D1 = 4 * P0_I_GU, P0_R_D2 = P0_R_D1 + P0_I_D, P0_R_IN = P0_R_D2 + P0_I_D, P0_R_OUT = P0_R_IN + P0_I_IN, P0_R_SMALL = P0_R_OUT + P0_I_OUT;
__device__ __forceinline__ void p0_convert_simple(Frame& F, int lo, int hi, int worker, int nworkers) {
    const int lane = (F.tid & 63), stride = nworkers * 8;
    LAS unsigned* T = (LAS unsigned*)(F.lds + F.wave * 16384);
    for (int it = lo + worker * 8 + F.wave; it < hi; it += stride) { f32x4 va[16]; float ga; P0Desc da; p0_decode(F, it, da); p0_load(va, ga, da, lane); p0_finish(va, ga, da, T, lane); }
}
__device__ __forceinline__ void tail_convert(Frame& F, int nwg, int lo, int hi) {
    const int r = nwg % F.G, c = (int)blockIdx.x;
    if (r == 0) p0_convert(F, lo, hi, c, F.G);
    else if (c >= r) p0_convert_simple(F, lo, hi, c - r, F.G - r);
}

__device__ __forceinline__ int gu_dest(int n, int bj) { return 256 * (n >> 7) + 128 * bj + (n & 127); }
__device__ __forceinline__ int q8(float x) { x = __builtin_rintf(x); x = x > 127.f ? 127.f : (x < -127.f ? -127.f : x); return (int)x; }
__device__ __forceinline__ unsigned pack4_i8(float a, float b, float c, float d) {
    unsigned w = __builtin_amdgcn_cvt_pk_u8_f32(a + 128.0f, 0u, 0u); w = __builtin_amdgcn_cvt_pk_u8_f32(b + 128.0f, 1u, w); w = __builtin_amdgcn_cvt_pk_u8_f32(c + 128.0f, 2u, w); w = __builtin_amdgcn_cvt_pk_u8_f32(d + 128.0f, 3u, w);
    return w ^ 0x80808080u;
}
constexpr int GU_STRIPS = 5504, GU_STRIPS_ALL = 5504 + 22 * 64;
template <int ROT>
__device__ __forceinline__ void gu_absmax(Frame& F, int s_lo, int s_hi) {
    const int gw = F.vcu * 8 + F.wave, NGW = F.G * 8, lane = (F.tid & 63), kr = lane >> 4, nq = lane & 15;
    for (int sidx = s_lo + gw; sidx < s_hi; sidx += NGW) {
        int q, r; if (sidx < GU_STRIPS) { q = sidx / 1376; r = sidx % 1376; } else if (sidx < GU_STRIPS_ALL) { q = 4; r = sidx - GU_STRIPS; } else { q = 5; r = sidx - GU_STRIPS_ALL; }
        const int nbk = q < 4 ? 172 : 64, kb = r / nbk, nb = r % nbk, rowlen = q < 4 ? FF : DM, ktot = q < 4 ? DM : FF;
        const float* W = q == 0 ? INP(2) : q == 1 ? INP(3) : q == 2 ? INP(18) : q == 3 ? INP(19) : q == 4 ? INP(20) : INP(4); const float* gain = q < 2 ? INP(1) : (q < 4 ? INP(17) : nullptr);
        unsigned* cmax = (unsigned*)(F.ws + WS_CTL + CTL_CMAX) + (q < 4 ? (q >> 1) * NGU : 2 * NGU + (q - 4) * DM);
        const int n = 64 * nb + 4 * nq;
        const float* src = W + (size_t)(512 * kb + 2 * kr) * rowlen + n;
        int ntl = (ktot - 512 * kb) / 64; ntl = ntl > 8 ? 8 : ntl;
        f32x4 cm = (f32x4){0.f, 0.f, 0.f, 0.f};
#pragma unroll 2
        for (int t = 0; t < ntl; ++t) {
            const float gv = gain ? gain[512 * kb + 64 * t + lane] : 1.0f;
            f32x4 v[16];
#pragma unroll
            for (int i = 0; i < 16; ++i) v[i] = *(const f32x4*)(src + (size_t)(64 * t + 8 * (i >> 1) + (i & 1)) * rowlen);
            if (ROT) {
#pragma unroll
                for (int st = 1; st <= (ROT <= 3 ? 1 : ROT == 4 ? 2 : 4); st <<= 1)
#pragma unroll
                    for (int i = 0; i < 16; ++i) if (!(i & st)) { const f32x4 a = v[i], b = v[i | st]; v[i] = a + b; v[i | st] = a - b; }
                { const bool s16 = (lane & 16) != 0, s32 = (lane & 32) != 0;
#pragma unroll
                  for (int i = 0; i < 16; ++i)
#pragma unroll
                      for (int e = 0; e < 4; ++e) { float x = v[i][e]; if (ROT >= 2) x = bfly16(x, s16); if (ROT >= 3) x = bfly32(x, s32); v[i][e] = x; } }
#pragma unroll
                for (int i = 0; i < 16; ++i) v[i] *= (ROT == 1 ? 0.70710678118654752f : ROT == 2 ? 0.5f : ROT == 3 ? 0.35355339059327373f : ROT == 4 ? 0.25f : 0.17677669529663687f);
            }
#pragma unroll
            for (int i = 0; i < 16; ++i) { const float g = __shfl(gv, 8 * (i >> 1) + 2 * kr + (i & 1)); const f32x4 a = __builtin_elementwise_abs(v[i] * g); cm = __builtin_elementwise_max(cm, a); }
        }
#pragma unroll
        for (int e = 0; e < 4; ++e) { float c = cm[e]; c = fmaxf(c, __shfl_xor(c, 16)); c = fmaxf(c, __shfl_xor(c, 32)); cm[e] = c; }
        if (kr == 0) {
            const int d0 = q < 4 ? gu_dest(n, q & 1) : n;
#pragma unroll
            for (int e = 0; e < 4; ++e) atomicMax(cmax + d0 + e, __float_as_uint(cm[e]));
        }
    }
}
struct GUDesc { const float* W; const float* gain; unsigned char* WQ; const unsigned* cmax; float* sb; int bj, k0, n0, N, kt8, il; };
constexpr int Q_R_D1Q = 5 * P0_I_GU;
constexpr int Q_R_D2 = 4 * P0_I_GU;
__device__ __forceinline__ void gu_decode(Frame& F, int it, GUDesc& d) {
    const int q = it / P0_I_GU, r = it % P0_I_GU;
    if (q < 4) { d.k0 = 128 * (r / 344); d.n0 = 32 * (r % 344); d.bj = q & 1; d.N = FF; d.kt8 = KT8; d.il = 1;
        d.W = q == 0 ? INP(2) : q == 1 ? INP(3) : q == 2 ? INP(18) : INP(19); d.gain = q < 2 ? INP(1) : INP(17);
        d.WQ = F.ws + (q < 2 ? WS_WGU1 : WS_WGU2); d.cmax = (const unsigned*)(F.ws + WS_CTL + CTL_CMAX) + (q >> 1) * NGU; d.sb = (float*)(F.ws + WS_SMALL + (q < 2 ? SM_SB1 : SM_SB2)); }
    else { d.k0 = 128 * (r / 128); d.n0 = 32 * (r % 128); d.bj = 0; d.N = DM; d.kt8 = FF / 128; d.il = 0; d.W = q == 4 ? INP(20) : INP(4); d.gain = nullptr;
        d.WQ = F.ws + (q == 4 ? WS_WD2 : WS_WD1); d.cmax = (const unsigned*)(F.ws + WS_CTL + CTL_CMAX) + 2 * NGU + (q == 4 ? 0 : DM); d.sb = (float*)(F.ws + WS_SMALL + (q == 4 ? SM_SB3 : SM_SB4)); }
}
__device__ __forceinline__ void gu_load(f32x4 (&v)[16], float& gA, float& gB, const GUDesc& d, int lane) {
    const int kr = lane >> 3, nq = lane & 7;
    const float* __restrict__ src = d.W + (size_t)(d.k0 + 4 * kr) * d.N + d.n0 + 4 * nq;
    gA = d.gain ? d.gain[d.k0 + lane] : 1.0f; gB = d.gain ? d.gain[d.k0 + 64 + lane] : 1.0f;
#pragma unroll
    for (int i = 0; i < 16; ++i) v[i] = *(const f32x4*)(src + (size_t)(32 * (i >> 2) + (i & 3)) * d.N);
}
template <int ROT>
__device__ __forceinline__ void rot32_tile(f32x4 (&v)[16], int lane) {
#pragma unroll
    for (int jq = 0; jq < 4; ++jq) {
        const f32x4 a = v[4 * jq], b = v[4 * jq + 1], c = v[4 * jq + 2], d = v[4 * jq + 3];
        const f32x4 a1 = a + b, b1 = a - b, c1 = c + d, d1 = c - d;
        if (ROT >= 2) { v[4 * jq] = a1 + c1; v[4 * jq + 2] = a1 - c1; v[4 * jq + 1] = b1 + d1; v[4 * jq + 3] = b1 - d1; }
        else { v[4 * jq] = a1; v[4 * jq + 1] = b1; v[4 * jq + 2] = c1; v[4 * jq + 3] = d1; }
    }
    { const bool s8 = (lane & 8) != 0, s16 = (lane & 16) != 0, s32 = (lane & 32) != 0;
#pragma unroll
      for (int i = 0; i < 16; ++i)
#pragma unroll
          for (int e = 0; e < 4; ++e) { float x = v[i][e]; if (ROT >= 3) x = bfly8(x, s8); if (ROT >= 4) x = bfly16(x, s16); if (ROT >= 5) x = bfly32(x, s32); v[i][e] = x; } }
#pragma unroll
    for (int i = 0; i < 16; ++i) v[i] *= (ROT == 1 ? 0.70710678118654752f : ROT == 2 ? 0.5f : ROT == 3 ? 0.35355339059327373f : ROT == 4 ? 0.25f : 0.17677669529663687f);
}
template <bool STRIP, int ROT>
__device__ __forceinline__ void gu_finish_t(f32x4 (&v)[16], float gA, float gB, const GUDesc& d, LAS unsigned* T, int lane, const float (&sinv)[4]) {
    const int kr = lane >> 3, nq = lane & 7;
    const int dq0 = d.il ? gu_dest(d.n0 + 4 * nq, d.bj) : d.n0 + 4 * nq;
    if (ROT) rot32_tile<ROT>(v, lane);
    float inv[4];
#pragma unroll
    for (int e = 0; e < 4; ++e) { if (STRIP) inv[e] = sinv[e]; else { const float cm = __uint_as_float(d.cmax[dq0 + e]); inv[e] = cm > 0.f ? 127.0f / cm : 0.f; } }
#pragma unroll
    for (int jq = 0; jq < 4; ++jq) {
        float g[4];
#pragma unroll
        for (int e2 = 0; e2 < 4; ++e2) g[e2] = jq < 2 ? __shfl(gA, 32 * jq + 4 * kr + e2) : __shfl(gB, 32 * (jq - 2) + 4 * kr + e2);
#pragma unroll
        for (int e = 0; e < 4; ++e)
            T[(4 * nq + e) * 33 + 8 * jq + kr] = pack4_i8(v[4 * jq + 0][e] * g[0] * inv[e], v[4 * jq + 1][e] * g[1] * inv[e], v[4 * jq + 2][e] * g[2] * inv[e], v[4 * jq + 3][e] * g[3] * inv[e]);
    }
    LDS_WAIT(); asm volatile("" ::: "memory");
    const int nl = lane >> 3, c = lane & 7;
#pragma unroll
    for (int g4 = 0; g4 < 4; ++g4) {
        const int nloc = 8 * g4 + nl, dr = d.il ? gu_dest(d.n0 + nloc, d.bj) : d.n0 + nloc;
        const LAS unsigned* t = T + nloc * 33 + 4 * c;
        u32x4 o; o.x = t[0]; o.y = t[1]; o.z = t[2]; o.w = t[3];
        *(u32x4*)(d.WQ + blk8_off(dr, d.k0 + 16 * c, d.kt8)) = o;
        if (!STRIP) if (d.k0 == 0 && c == 0) d.sb[dr] = __uint_as_float(d.cmax[dr]) * (1.0f / 127.0f);
    }
    LDS_WAIT(); asm volatile("" ::: "memory");
}
template <int ROT>
__device__ __forceinline__ void gu_finish(f32x4 (&v)[16], float gA, float gB, const GUDesc& d, LAS unsigned* T, int lane) {
    const float z[4] = {0.f, 0.f, 0.f, 0.f}; gu_finish_t<false, ROT>(v, gA, gB, d, T, lane, z);
}
constexpr int GU_UNITS_GU = 4 * 344, GU_UNITS_ALL = GU_UNITS_GU + 128;
__device__ __forceinline__ void gu_strip(Frame& F, int uidx, int par) {
    const int lane = (F.tid & 63), kr = lane >> 3, nq = lane & 7;
    const int q = uidx < GU_UNITS_GU ? uidx / 344 : 4, nb = uidx < GU_UNITS_GU ? uidx % 344 : uidx - GU_UNITS_GU;
    const int nkt = q < 4 ? 32 : 86, it0 = q * P0_I_GU + nb, its = q < 4 ? 344 : 128;
    LAS unsigned* T = (LAS unsigned*)(F.lds + F.wave * 16384);
    LAS float* part = (LAS float*)(F.lds + 131072 + 1024 * (par & 1));
    GUDesc d; gu_decode(F, it0, d);
    f32x4 cm = {0.f, 0.f, 0.f, 0.f};
    for (int kt = F.wave; kt < nkt; kt += 8) {
        f32x4 v[16]; float gA, gB; d.k0 = 128 * kt; gu_load(v, gA, gB, d, lane);
#pragma unroll
        for (int jq = 0; jq < 4; ++jq) {
#pragma unroll
            for (int e2 = 0; e2 < 4; ++e2) {
                const float g = jq < 2 ? __shfl(gA, 32 * jq + 4 * kr + e2) : __shfl(gB, 32 * (jq - 2) + 4 * kr + e2);
#pragma unroll
                for (int e = 0; e < 4; ++e) cm[e] = fmaxf(cm[e], fabsf(v[4 * jq + e2][e] * g));
            }
        }
    }
#pragma unroll
    for (int e = 0; e < 4; ++e) { float m = cm[e]; m = fmaxf(m, __shfl_xor(m, 8)); m = fmaxf(m, __shfl_xor(m, 16)); m = fmaxf(m, __shfl_xor(m, 32)); cm[e] = m; }
    if (kr == 0) { for (int e = 0; e < 4; ++e) part[F.wave * 32 + 4 * nq + e] = cm[e]; }
    __syncthreads();
    float inv[4];
#pragma unroll
    for (int e = 0; e < 4; ++e) {
        float m = 0.f;
#pragma unroll
        for (int w = 0; w < 8; ++w) m = fmaxf(m, part[w * 32 + 4 * nq + e]);
        inv[e] = m > 0.f ? 127.0f / m : 0.f;
        if (F.wave == 0 && kr == 0) { const int n = d.n0 + 4 * nq + e; d.sb[d.il ? gu_dest(n, d.bj) : n] = m * (1.0f / 127.0f); }
    }
    for (int kt = F.wave; kt < nkt; kt += 8) {
        f32x4 v[16]; float gA, gB; d.k0 = 128 * kt; gu_load(v, gA, gB, d, lane);
        gu_finish_t<true, 0>(v, gA, gB, d, T, lane, inv);
    }
    (void)its;
}
__device__ __forceinline__ void gu_strips(Frame& F, int lo, int hi, int worker, int nworkers) {
    int par = 0;
    for (int u = lo + worker; u < hi; u += nworkers, ++par) gu_strip(F, u, par);
}
__device__ __forceinline__ void tail_strips(Frame& F, int nwg, int lo, int hi) {
    const int r = nwg % F.G, c = (int)blockIdx.x;
    if (r == 0) gu_strips(F, lo, hi, c, F.G);
    else if (c >= r) gu_strips(F, lo, hi, c - r, F.G - r);
}
template <int ROT = 0>
__device__ __forceinline__ void gu_quant(Frame& F, int lo, int hi, int worker, int nworkers) {
    const int lane = (F.tid & 63), stride = nworkers * 8, first = lo + worker * 8 + F.wave;
    LAS unsigned* T = (LAS unsigned*)(F.lds + F.wave * 16384);
    if (first >= hi) return;
    const int n_my = (hi - first + stride - 1) / stride;
    f32x4 va[16], vb[16]; float gaA, gaB, gbA, gbB; GUDesc da, db;
    gu_decode(F, first, da); gu_load(va, gaA, gaB, da, lane);
    for (int i = 0; i < n_my; i += 2) {
        { const int j = i + 1 < n_my ? i + 1 : n_my - 1; gu_decode(F, first + j * stride, db); gu_load(vb, gbA, gbB, db, lane); }
        gu_finish<ROT>(va, gaA, gaB, da, T, lane);
        { const int j = i + 2 < n_my ? i + 2 : n_my - 1; gu_decode(F, first + j * stride, da); gu_load(va, gaA, gaB, da, lane); }
        if (i + 1 < n_my) gu_finish<ROT>(vb, gbA, gbB, db, T, lane);
    }
}
template <int ROT = 0>
__device__ __forceinline__ void gu_quant_simple(Frame& F, int lo, int hi, int worker, int nworkers) {
    const int lane = (F.tid & 63), stride = nworkers * 8;
    LAS unsigned* T = (LAS unsigned*)(F.lds + F.wave * 16384);
    for (int it = lo + worker * 8 + F.wave; it < hi; it += stride) { f32x4 va[16]; float gA, gB; GUDesc da; gu_decode(F, it, da); gu_load(va, gA, gB, da, lane); gu_finish<ROT>(va, gA, gB, da, T, lane); }
}
template <int ROT = 0>
__device__ __forceinline__ void tail_quant(Frame& F, int nwg, int lo, int hi) {
    const int r = nwg % F.G, c = (int)blockIdx.x;
    if (r == 0) gu_quant<ROT>(F, lo, hi, c, F.G);
    else if (c >= r) gu_quant_simple<ROT>(F, lo, hi, c - r, F.G - r);
}
__device__ __forceinline__ void quant_rows(Frame& F, const float* x, unsigned char* xq, float* ra) {
    const int gw = F.vcu * 8 + F.wave, NGW = F.G * 8, lane = (F.tid & 63);
    for (int m = gw; m < M; m += NGW) {
        const f32x4* xr = (const f32x4*)(x + (size_t)m * DM) + lane;
        f32x4 v[16]; float s = 0.f, am = 0.f;
#pragma unroll
        for (int j = 0; j < 16; ++j) { v[j] = xr[64 * j]; s += (v[j].x * v[j].x + v[j].y * v[j].y) + (v[j].z * v[j].z + v[j].w * v[j].w);
            am = fmaxf(fmaxf(am, fmaxf(__builtin_fabsf(v[j].x), __builtin_fabsf(v[j].y))), fmaxf(__builtin_fabsf(v[j].z), __builtin_fabsf(v[j].w))); }
        s = wave_sum(s);
#pragma unroll
        for (int o = 1; o < 64; o <<= 1) am = fmaxf(am, __shfl_xor(am, o));
        const float inv = am > 0.f ? 127.0f / am : 0.f;
#pragma unroll
        for (int j = 0; j < 16; ++j) *(unsigned*)(xq + blk8_off(m, 4 * lane + 256 * j, KT8)) = pack4_i8(v[j].x * inv, v[j].y * inv, v[j].z * inv, v[j].w * inv);
        if (lane == 0) ra[m] = __builtin_amdgcn_rsqf(s * (1.0f / DM) + EPS) * am * (1.0f / 127.0f);
    }
}

__device__ __forceinline__ float bflyq1(float x, bool up) { const float p = __uint_as_float(__builtin_amdgcn_update_dpp(0u, __float_as_uint(x), 0xB1, 0xf, 0xf, false)); return up ? p - x : x + p; }
__device__ __forceinline__ float bflyq2(float x, bool up) { const float p = __uint_as_float(__builtin_amdgcn_update_dpp(0u, __float_as_uint(x), 0x4E, 0xf, 0xf, false)); return up ? p - x : x + p; }
__device__ __forceinline__ void qh_load(u32x4 (&v)[22], const bf16_t* hidp, int unit, int rl, int c, int kt0, int nk) {
    const bf16_t* src = hidp + blk_off(unit * 8 + rl, 64 * kt0, KTF) + 8 * c;
#pragma unroll
    for (int t = 0; t < 22; ++t) { const int tt = t < nk ? t : nk - 1; v[t] = *(const u32x4*)(src + (size_t)tt * (256 * 64)); }
}
template <int ROT>
__device__ __forceinline__ void qh_process(Frame& F, u32x4 (&v)[22], unsigned char* hq, float* sh, int unit, int par, int rl, int c, int kt0, int nk, const bf16_t* hidp, int next_unit) {
    LAS unsigned* part = (LAS unsigned*)(F.lds + 131072);
    const int wave = F.wave, row = unit * 8 + rl;
    const bool u1 = (c & 1) != 0, u2 = (c & 2) != 0;
    unsigned mb = 0u;
#pragma unroll
    for (int t = 0; t < 22; ++t) {
        float f0 = __uint_as_float(v[t].x << 16), f1 = __uint_as_float(v[t].x & 0xffff0000u), f2 = __uint_as_float(v[t].y << 16), f3 = __uint_as_float(v[t].y & 0xffff0000u);
        float f4 = __uint_as_float(v[t].z << 16), f5 = __uint_as_float(v[t].z & 0xffff0000u), f6 = __uint_as_float(v[t].w << 16), f7 = __uint_as_float(v[t].w & 0xffff0000u);
        u32x4 w = v[t];
        if (ROT) {
#define FW_BF(a, b) { const float t_ = a; a = t_ + b; b = t_ - b; }
            FW_BF(f0, f1) FW_BF(f2, f3) FW_BF(f4, f5) FW_BF(f6, f7)
            if (ROT >= 2) { FW_BF(f0, f2) FW_BF(f1, f3) FW_BF(f4, f6) FW_BF(f5, f7) }
            if (ROT >= 3) { FW_BF(f0, f4) FW_BF(f1, f5) FW_BF(f2, f6) FW_BF(f3, f7) }
#undef FW_BF
            const float sc = (ROT == 1 ? 0.70710678118654752f : ROT == 2 ? 0.5f : ROT == 3 ? 0.35355339059327373f : ROT == 4 ? 0.25f : 0.17677669529663687f);
#define FW_Q(f) { if (ROT >= 4) f = bflyq1(f, u1); if (ROT >= 5) f = bflyq2(f, u2); f *= sc; }
            FW_Q(f0) FW_Q(f1) FW_Q(f2) FW_Q(f3) FW_Q(f4) FW_Q(f5) FW_Q(f6) FW_Q(f7)
#undef FW_Q
            w.x = cvt_pk_bf16(f0, f1); w.y = cvt_pk_bf16(f2, f3); w.z = cvt_pk_bf16(f4, f5); w.w = cvt_pk_bf16(f6, f7);
            v[t] = w;
        }
#pragma unroll
        for (int e = 0; e < 4; ++e) { const unsigned x = w[e]; const unsigned lo = (x << 16) & 0x7fff0000u, hi2 = x & 0x7fff0000u; mb = mb > lo ? mb : lo; mb = mb > hi2 ? mb : hi2; }
    }
    { unsigned o1 = __shfl_xor(mb, 1); mb = mb > o1 ? mb : o1; o1 = __shfl_xor(mb, 2); mb = mb > o1 ? mb : o1; o1 = __shfl_xor(mb, 4); mb = mb > o1 ? mb : o1; }
    if (c == 0) part[(par * 8 + wave) * 8 + rl] = mb;
    __syncthreads();
    mb = 0u;
#pragma unroll
    for (int w8 = 0; w8 < 8; ++w8) { const unsigned o1 = part[(par * 8 + w8) * 8 + rl]; mb = mb > o1 ? mb : o1; }
    const float am = __uint_as_float(mb), inv = am > 0.f ? 127.0f / am : 0.f;
    if (wave == 0 && c == 0) sh[row] = am * (1.0f / 127.0f);
#pragma unroll
    for (int t = 0; t < 22; ++t) if (t < nk) {
        typedef unsigned u32x2_t __attribute__((ext_vector_type(2)));
        u32x2_t o;
        o.x = pack4_i8(__uint_as_float(v[t].x << 16) * inv, __uint_as_float(v[t].x & 0xffff0000u) * inv, __uint_as_float(v[t].y << 16) * inv, __uint_as_float(v[t].y & 0xffff0000u) * inv);
        o.y = pack4_i8(__uint_as_float(v[t].z << 16) * inv, __uint_as_float(v[t].z & 0xffff0000u) * inv, __uint_as_float(v[t].w << 16) * inv, __uint_as_float(v[t].w & 0xffff0000u) * inv);
        *(u32x2_t*)(hq + blk8_off(row, 64 * (kt0 + t) + 8 * c, FF / 128)) = o;
    }
    if (next_unit >= 0) qh_load(v, hidp, next_unit, rl, c, kt0, nk);
}
template <int ROT>
__device__ __forceinline__ void quant_hid_rot(Frame& F, const bf16_t* hidp, unsigned char* hq, float* sh) {
    const int lane = (F.tid & 63), kq = lane >> 3, c = lane & 7;
    const int gw = F.vcu * 8 + F.wave, NGW = F.G * 8;
    const bool u1 = (c & 1) != 0, u2 = (c & 2) != 0, lastok = kq < 4;
    for (int row = gw; row < M; row += NGW) {
        const bf16_t* src = hidp + blk_off(row, 64 * kq, KTF) + 8 * c;
        u32x4 v[22];
#pragma unroll
        for (int j = 0; j < 22; ++j) v[j] = *(const u32x4*)(src + (size_t)((j < 21 || lastok) ? 8 * j : 0) * (256 * 64));
        float am = 0.f;
#pragma unroll
        for (int j = 0; j < 22; ++j) {
            float f0 = __uint_as_float(v[j].x << 16), f1 = __uint_as_float(v[j].x & 0xffff0000u), f2 = __uint_as_float(v[j].y << 16), f3 = __uint_as_float(v[j].y & 0xffff0000u);
            float f4 = __uint_as_float(v[j].z << 16), f5 = __uint_as_float(v[j].z & 0xffff0000u), f6 = __uint_as_float(v[j].w << 16), f7 = __uint_as_float(v[j].w & 0xffff0000u);
            if (ROT) {
#define FW_BF(a, b) { const float t_ = a; a = t_ + b; b = t_ - b; }
                FW_BF(f0, f1) FW_BF(f2, f3) FW_BF(f4, f5) FW_BF(f6, f7)
                if (ROT >= 2) { FW_BF(f0, f2) FW_BF(f1, f3) FW_BF(f4, f6) FW_BF(f5, f7) }
                if (ROT >= 3) { FW_BF(f0, f4) FW_BF(f1, f5) FW_BF(f2, f6) FW_BF(f3, f7) }
#undef FW_BF
                const float sc = (ROT == 1 ? 0.70710678118654752f : ROT == 2 ? 0.5f : ROT == 3 ? 0.35355339059327373f : ROT == 4 ? 0.25f : 0.17677669529663687f);
#define FW_Q(f) { if (ROT >= 4) f = bflyq1(f, u1); if (ROT >= 5) f = bflyq2(f, u2); f *= sc; }
                FW_Q(f0) FW_Q(f1) FW_Q(f2) FW_Q(f3) FW_Q(f4) FW_Q(f5) FW_Q(f6) FW_Q(f7)
#undef FW_Q
                u32x4 w; w.x = cvt_pk_bf16(f0, f1); w.y = cvt_pk_bf16(f2, f3); w.z = cvt_pk_bf16(f4, f5); w.w = cvt_pk_bf16(f6, f7);
                v[j] = w;
            }
            am = fmaxf(fmaxf(am, fmaxf(__builtin_fabsf(f0), __builtin_fabsf(f1))), fmaxf(__builtin_fabsf(f2), __builtin_fabsf(f3)));
            am = fmaxf(fmaxf(am, fmaxf(__builtin_fabsf(f4), __builtin_fabsf(f5))), fmaxf(__builtin_fabsf(f6), __builtin_fabsf(f7)));
        }
#pragma unroll
        for (int o = 1; o < 64; o <<= 1) am = fmaxf(am, __shfl_xor(am, o));
        am *= 1.00390625f;
        const float inv = am > 0.f ? 127.0f / am : 0.f;
        if (lane == 0) sh[row] = am * (1.0f / 127.0f);
#pragma unroll
        for (int j = 0; j < 22; ++j) if (j < 21 || lastok) {
            typedef unsigned u32x2_t __attribute__((ext_vector_type(2)));
            u32x2_t o;
            o.x = pack4_i8(__uint_as_float(v[j].x << 16) * inv, __uint_as_float(v[j].x & 0xffff0000u) * inv, __uint_as_float(v[j].y << 16) * inv, __uint_as_float(v[j].y & 0xffff0000u) * inv);
            o.y = pack4_i8(__uint_as_float(v[j].z << 16) * inv, __uint_as_float(v[j].z & 0xffff0000u) * inv, __uint_as_float(v[j].w << 16) * inv, __uint_as_float(v[j].w & 0xffff0000u) * inv);
            *(u32x2_t*)(hq + blk8_off(row, 64 * (8 * j + kq) + 8 * c, FF / 128)) = o;
        }
    }
}
__device__ __forceinline__ void quant_hid(Frame& F) {
    const int gw = F.vcu * 8 + F.wave, NGW = F.G * 8, lane = (F.tid & 63), rloc = lane >> 3, c = lane & 7;
    const bf16_t* hidp = (const bf16_t*)(F.ws + WS_HID); unsigned char* hq = F.ws + WS_HIDQ;
    const unsigned* rmax = (const unsigned*)(F.ws + WS_CTL + CTL_RMAX); float* sh = (float*)(F.ws + WS_SMALL + SM_SH);
    for (int it = gw; it < 32 * 86 * 2; it += NGW) {
        const int half = it & 1, kt8 = (it >> 1) % 86, pm = (it >> 1) / 86;
        const bf16_t* src = hidp + ((size_t)(pm * KTF + 2 * kt8 + (c >> 2)) * 256) * 64 + 16 * (c & 3);
        unsigned char* dst = hq + ((size_t)(pm * 86 + kt8) * 256) * 128 + 16 * c;
#pragma unroll 4
        for (int i = 0; i < 16; ++i) {
            const int rl = 128 * half + 8 * i + rloc, row = 256 * pm + rl;
            const float am = __uint_as_float(rmax[row]); const float inv = am > 0.f ? 127.0f / am : 0.f;
            const u32x4 a = *(const u32x4*)(src + (size_t)rl * 64), b = *(const u32x4*)(src + (size_t)rl * 64 + 8);
            u32x4 o;
#define Q2(x, y) pack4_i8(__uint_as_float((x) << 16) * inv, __uint_as_float((x) & 0xffff0000u) * inv, __uint_as_float((y) << 16) * inv, __uint_as_float((y) & 0xffff0000u) * inv)
            o.x = Q2(a.x, a.y); o.y = Q2(a.z, a.w); o.z = Q2(b.x, b.y); o.w = Q2(b.z, b.w);
#undef Q2
            *(u32x4*)(dst + (size_t)rl * 128) = o;
            if (kt8 == 0 && c == 0) sh[row] = am * (1.0f / 127.0f);
        }
    }
}

__device__ __forceinline__ void p0_prologue(Frame& F) {
    const int gw = F.vcu * 8 + F.wave, NGW = F.G * 8, lane = (F.tid & 63);
    unsigned char* ws = F.ws;
    p0_convert(F, P0_R_IN, P0_R_OUT, F.vcu, F.G);
    gu_quant<ROT1>(F, Q_R_D1Q, Q_R_D1Q + 5408, F.vcu, F.G);
    gu_quant<ROT2>(F, Q_R_D2, Q_R_D2 + 1708, F.vcu, F.G);
    p0_convert(F, P0_R_SMALL, P0_NITEMS, F.vcu, F.G);
    quant_rows(F, INP(0), F.ws + WS_XQ, (float*)(F.ws + WS_SMALL + SM_RA0));
    for (int t = gw; t < 256; t += NGW) {
        const int kv = t >> 7, ch = t & 127; const float* pos = (kv ? INP(10) : INP(7)) + ch * 32; const float* W1 = (kv ? INP(11) : INP(8)) + (size_t)ch * 32 * 128;
        float a0 = 0.f, a1 = 0.f;
#pragma unroll 8
        for (int k = 0; k < 32; ++k) { const float p = pos[k]; a0 += p * W1[k * 128 + lane]; a1 += p * W1[k * 128 + 64 + lane]; }
        float* pb = (float*)(ws + WS_SMALL + SM_PBP) + (size_t)t * 128; pb[lane] = a0; pb[64 + lane] = a1;
    }
    gu_strips(F, 0, 688, F.vcu, F.G);
    if (gw < 6) { u32x4* p = (u32x4*)(ws + WS_KV + (size_t)gw * KV_STRIDE_B + 8 * MiB); for (int i = lane; i < 4096; i += 64) p[i] = (u32x4){0u, 0u, 0u, 0u}; }
}

__device__ __forceinline__ void compress_unit(Frame& F, int kv, int rt) {
    const int tid = F.tid, lane = (F.tid & 63), wid = F.wave, r32 = lane & 31, hi = lane >> 5;
    unsigned char* ws = F.ws;
    const bf16_t* Af = (const bf16_t*)(ws + WS_KV + (size_t)kv * KV_STRIDE_B);
    const bf16_t* W1t = (const bf16_t*)(ws + WS_SMALL + (kv ? SM_WCV1 : SM_WCK1));
    const bf16_t* W2t = (const bf16_t*)(ws + WS_SMALL + (kv ? SM_WCV2 : SM_WCK2));
    bf16_t* outp = (bf16_t*)(ws + (kv ? WS_VCMP : WS_KCMP));
    const int R0 = rt * 32;
    LAS float* red = (LAS float*)F.lds;
    __syncthreads();
    f32x16 acc[4];
#pragma unroll
    for (int nb = 0; nb < 4; ++nb) acc[nb] = f32x16{};
    const bf16_t* ap = Af + (size_t)(R0 + r32) * 2048 + wid * 512 + hi * 8;
    const bf16_t* bp = W1t + (size_t)r32 * 4096 + wid * 512 + hi * 8;
#pragma unroll 8
    for (int ks = 0; ks < 32; ++ks) {
        const bf16x8 a = *(const bf16x8*)(ap + ks * 16);
#pragma unroll
        for (int nb = 0; nb < 4; ++nb) { const bf16x8 b = *(const bf16x8*)(bp + (size_t)nb * 32 * 4096 + ks * 16); acc[nb] = __builtin_amdgcn_mfma_f32_32x32x16_bf16(a, b, acc[nb], 0, 0, 0); }
    }
#pragma unroll
    for (int nb = 0; nb < 4; ++nb)
#pragma unroll
        for (int r = 0; r < 16; ++r) red[(wid * 32 + ((r & 3) + 8 * (r >> 2) + 4 * hi)) * 128 + nb * 32 + r32] = acc[nb][r];
    __syncthreads();
    float hv[8];
    {
        const int n = tid & 127;
        const float pbias = ((const float*)(ws + WS_CTL + CTL_PBSUM))[kv * 128 + n];
#pragma unroll
        for (int e = 0; e < 8; ++e) { const int c = (tid >> 7) * 8 + e; float s = 0.f;
#pragma unroll
            for (int w = 0; w < 8; ++w) s += red[(w * 32 + c) * 128 + n];
            s += pbias; hv[e] = s * __builtin_amdgcn_rcpf(1.0f + __builtin_amdgcn_exp2f(-s * LOG2E)); }
    }
    __syncthreads();
    LAS bf16_t* h1 = (LAS bf16_t*)F.lds;
    { const int n = tid & 127;
#pragma unroll
        for (int e = 0; e < 8; ++e) { const int c = (tid >> 7) * 8 + e; h1[c * 136 + n] = (bf16_t)f2bf(hv[e]); } }
    __syncthreads();
    if (wid < 4) {
        f32x16 o = f32x16{};
#pragma unroll
        for (int ks = 0; ks < 8; ++ks) {
            const bf16x8 a = *(const LAS bf16x8*)(h1 + r32 * 136 + ks * 16 + hi * 8);
            const bf16x8 b = *(const bf16x8*)(W2t + (size_t)(wid * 32 + r32) * 128 + ks * 16 + hi * 8);
            o = __builtin_amdgcn_mfma_f32_32x32x16_bf16(a, b, o, 0, 0, 0);
        }
#pragma unroll
        for (int r = 0; r < 16; ++r) outp[(size_t)(R0 + (r & 3) + 8 * (r >> 2) + 4 * hi) * 128 + wid * 32 + r32] = (bf16_t)f2bf(o[r]);
    }
    __syncthreads();
}

template <int W>
__device__ __forceinline__ void pool_d_seg(const float* ub, bf16_t* db, int t0, int cq) {
    f32x4 ring[W]; f32x4 sum = (f32x4){0.f, 0.f, 0.f, 0.f};
    const int tp0 = t0 & 2047;
#pragma unroll
    for (int i = 0; i < W; ++i) { ring[i] = (tp0 - W + i >= 0) ? *(const f32x4*)(ub + (size_t)(t0 - W + i) * DPOOL + 4 * cq) : (f32x4){0.f, 0.f, 0.f, 0.f}; sum += ring[i]; }
    for (int c0 = 0; c0 < 32; c0 += W) {
#pragma unroll
        for (int i = 0; i < W; ++i) {
            const int t = t0 + c0 + i; const f32x4 x = *(const f32x4*)(ub + (size_t)t * DPOOL + 4 * cq);
            sum = sum + x - ring[i]; ring[i] = x;
            const int tp = tp0 + c0 + i; const float inv = 1.0f / (float)(tp + 1 < W ? tp + 1 : W);
            const f32x4 d = sum * inv - x;
            u32x2 w; w.x = cvt_pk_bf16(d.x, d.y); w.y = cvt_pk_bf16(d.z, d.w);
            *(u32x2*)(db + (size_t)(cq >> 7) * M * 512 + blk_off(t, (4 * cq) & 511, KTP)) = w;
        }
    }
}
__device__ __forceinline__ void pool_d_unit(Frame& F, int seg) {
    const float* ub = (const float*)(F.ws + WS_U); bf16_t* db = (bf16_t*)(F.ws + WS_DPOOL);
    const int cq = F.tid, gi = cq >> 7, t0 = seg * 32;
    if (gi == 0) pool_d_seg<2>(ub, db, t0, cq); else if (gi == 1) pool_d_seg<4>(ub, db, t0, cq); else if (gi == 2) pool_d_seg<8>(ub, db, t0, cq); else pool_d_seg<16>(ub, db, t0, cq);
}

constexpr int SHM_T = 64 * 128 * 2;
constexpr int AT_V = 0  , AT_K = 3 * SHM_T  , AT_WS = 5 * SHM_T  , AT_LUT = AT_WS + 2048  , AT_GL = AT_LUT + 4 * 304 * 4  ;
constexpr int AT_SEL = AT_GL + 3072  , AT_IMPS = AT_SEL + 256  , AT_IMPH = AT_IMPS + 64 * 33 * 4  , AT_END = AT_IMPH + 4 * 64 * 33 * 4;
static_assert(AT_END <= CTRL_OFF, "attention LDS");
#define KSWZ(row, colB) ((row) * 256 + ((colB) ^ (((row) & 7) << 4)))
#define SBAR() __builtin_amdgcn_sched_barrier(0)
__device__ __forceinline__ int v_st(int k, int c) { const int kk = (k & ~0xC) | ((k & 4) << 1) | ((k & 8) >> 1); return ((kk >> 3) * 4 + (c >> 5)) * 512 + ((kk & 7) * 32 + (c & 31)) * 2; }
__device__ __forceinline__ int v_rd_base(int lane) { return ((lane & 3) << 3) | (((lane >> 2) & 3) << 6) | (((lane >> 4) & 1) << 5) | (((lane >> 5) & 1) << 8); }
constexpr int v_rd_off(int d0, int ks, int half) { return d0 * 512 + ks * 4096 + half * 2048; }
__device__ __forceinline__ int crow(int r, int hi) { return (r & 3) + 8 * (r >> 2) + 4 * hi; }

__device__ __forceinline__ void qkt(f32x16& p0, f32x16& p1, const LAS unsigned char* Kt, int r32, int hi, const bf16x8* qr, float init) {
    f32x16 zi;
#pragma unroll
    for (int r = 0; r < 16; ++r) zi[r] = init;
    const int kt = (int)(uintptr_t)Kt;
    const int a0 = kt + KSWZ(r32, (0 * 16 + hi * 8) * 2), a1 = kt + KSWZ(r32, (1 * 16 + hi * 8) * 2), a2 = kt + KSWZ(r32, (2 * 16 + hi * 8) * 2), a3 = kt + KSWZ(r32, (3 * 16 + hi * 8) * 2);
#define DSR128(dst, addr, off) asm volatile("ds_read_b128 %0, %1 offset:%2" : "=&v"(dst) : "v"(addr), "i"(off) : "memory")
    bf16x8 f0, f1, f2, f3, g0, g1, g2, g3, f4, f5, f6, f7, g4, g5, g6, g7;
    DSR128(f0, a0, 0); DSR128(g0, a0, 8192); DSR128(f1, a1, 0); DSR128(g1, a1, 8192); DSR128(f2, a2, 0); DSR128(g2, a2, 8192); DSR128(f3, a3, 0); DSR128(g3, a3, 8192);
    asm volatile("s_waitcnt lgkmcnt(0)" : "+v"(f0), "+v"(g0), "+v"(f1), "+v"(g1), "+v"(f2), "+v"(g2), "+v"(f3), "+v"(g3) :: "memory");
    DSR128(f4, a0, 128); DSR128(g4, a0, 8320); DSR128(f5, a1, 128); DSR128(g5, a1, 8320); DSR128(f6, a2, 128); DSR128(g6, a2, 8320); DSR128(f7, a3, 128); DSR128(g7, a3, 8320);
    SBAR();
    p0 = __builtin_amdgcn_mfma_f32_32x32x16_bf16(f0, qr[0], zi, 0, 0, 0); p1 = __builtin_amdgcn_mfma_f32_32x32x16_bf16(g0, qr[0], zi, 0, 0, 0);
    p0 = __builtin_amdgcn_mfma_f32_32x32x16_bf16(f1, qr[1], p0, 0, 0, 0); p1 = __builtin_amdgcn_mfma_f32_32x32x16_bf16(g1, qr[1], p1, 0, 0, 0);
    p0 = __builtin_amdgcn_mfma_f32_32x32x16_bf16(f2, qr[2], p0, 0, 0, 0); p1 = __builtin_amdgcn_mfma_f32_32x32x16_bf16(g2, qr[2], p1, 0, 0, 0);
    p0 = __builtin_amdgcn_mfma_f32_32x32x16_bf16(f3, qr[3], p0, 0, 0, 0); p1 = __builtin_amdgcn_mfma_f32_32x32x16_bf16(g3, qr[3], p1, 0, 0, 0);
    asm volatile("s_waitcnt lgkmcnt(0)" : "+v"(f4), "+v"(g4), "+v"(f5), "+v"(g5), "+v"(f6), "+v"(g6), "+v"(f7), "+v"(g7) :: "memory");
    SBAR();
    p0 = __builtin_amdgcn_mfma_f32_32x32x16_bf16(f4, qr[4], p0, 0, 0, 0); p1 = __builtin_amdgcn_mfma_f32_32x32x16_bf16(g4, qr[4], p1, 0, 0, 0);
    p0 = __builtin_amdgcn_mfma_f32_32x32x16_bf16(f5, qr[5], p0, 0, 0, 0); p1 = __builtin_amdgcn_mfma_f32_32x32x16_bf16(g5, qr[5], p1, 0, 0, 0);
    p0 = __builtin_amdgcn_mfma_f32_32x32x16_bf16(f6, qr[6], p0, 0, 0, 0); p1 = __builtin_amdgcn_mfma_f32_32x32x16_bf16(g6, qr[6], p1, 0, 0, 0);
    p0 = __builtin_amdgcn_mfma_f32_32x32x16_bf16(f7, qr[7], p0, 0, 0, 0); p1 = __builtin_amdgcn_mfma_f32_32x32x16_bf16(g7, qr[7], p1, 0, 0, 0);
#undef DSR128
}
__device__ __forceinline__ void lut_add(f32x16& p0, f32x16& p1, const LAS float* lb) {
    const int la = (int)(uintptr_t)lb;
    float t0[16], t1[16];
#define DSR32(dst, off) asm volatile("ds_read_b32 %0, %1 offset:%2" : "=&v"(dst) : "v"(la), "i"(off) : "memory")
#define LUT_RD(r) do { constexpr int c_ = ((r) & 3) + 8 * ((r) >> 2); DSR32(t0[r], (59 - c_) * 4); DSR32(t1[r], (27 - c_) * 4); } while (0)
    LUT_RD(0); LUT_RD(1); LUT_RD(2); LUT_RD(3); LUT_RD(4); LUT_RD(5); LUT_RD(6); LUT_RD(7); LUT_RD(8); LUT_RD(9); LUT_RD(10); LUT_RD(11); LUT_RD(12); LUT_RD(13); LUT_RD(14); LUT_RD(15);
#undef LUT_RD
#undef DSR32
    asm volatile("s_waitcnt lgkmcnt(0)" : "+v"(t0[0]), "+v"(t0[1]), "+v"(t0[2]), "+v"(t0[3]), "+v"(t0[4]), "+v"(t0[5]), "+v"(t0[6]), "+v"(t0[7]), "+v"(t0[8]), "+v"(t0[9]), "+v"(t0[10]), "+v"(t0[11]), "+v"(t0[12]), "+v"(t0[13]), "+v"(t0[14]), "+v"(t0[15]) :: "memory");
    asm volatile("" : "+v"(t1[0]), "+v"(t1[1]), "+v"(t1[2]), "+v"(t1[3]), "+v"(t1[4]), "+v"(t1[5]), "+v"(t1[6]), "+v"(t1[7]), "+v"(t1[8]), "+v"(t1[9]), "+v"(t1[10]), "+v"(t1[11]), "+v"(t1[12]), "+v"(t1[13]), "+v"(t1[14]), "+v"(t1[15]) :: "memory");
    SBAR();
#pragma unroll
    for (int r = 0; r < 16; ++r) { p0[r] += t0[r]; p1[r] += t1[r]; }
}
__device__ __forceinline__ void pv_tile(f32x16* o, int vb, bf16x8 pa0, bf16x8 pa1, bf16x8 pa2, bf16x8 pa3) {
#define TRRD(dst, off) asm volatile("ds_read_b64_tr_b16 %0, %1 offset:%2" : "=&v"(dst) : "v"(vb), "i"(off) : "memory")
#define PV_D0(d0) do { s16x4 l0, l1, l2, l3, h0, h1, h2, h3; constexpr int b_ = v_rd_off(d0, 0, 0); \
        TRRD(l0, b_); TRRD(h0, b_ + 2048); TRRD(l1, b_ + 4096); TRRD(h1, b_ + 6144); TRRD(l2, b_ + 8192); TRRD(h2, b_ + 10240); TRRD(l3, b_ + 12288); TRRD(h3, b_ + 14336); \
        asm volatile("s_waitcnt lgkmcnt(0)" ::: "memory"); SBAR(); \
        o[d0] = __builtin_amdgcn_mfma_f32_32x32x16_bf16(pa0, (bf16x8){l0[0], l0[1], l0[2], l0[3], h0[0], h0[1], h0[2], h0[3]}, o[d0], 0, 0, 0); \
        o[d0] = __builtin_amdgcn_mfma_f32_32x32x16_bf16(pa1, (bf16x8){l1[0], l1[1], l1[2], l1[3], h1[0], h1[1], h1[2], h1[3]}, o[d0], 0, 0, 0); \
        o[d0] = __builtin_amdgcn_mfma_f32_32x32x16_bf16(pa2, (bf16x8){l2[0], l2[1], l2[2], l2[3], h2[0], h2[1], h2[2], h2[3]}, o[d0], 0, 0, 0); \
        o[d0] = __builtin_amdgcn_mfma_f32_32x32x16_bf16(pa3, (bf16x8){l3[0], l3[1], l3[2], l3[3], h3[0], h3[1], h3[2], h3[3]}, o[d0], 0, 0, 0); } while (0)
    PV_D0(0); PV_D0(1); PV_D0(2); PV_D0(3);
#undef PV_D0
#undef TRRD
}
__device__ __forceinline__ void pack_p(const f32x16& p0, const f32x16& p1, bf16x8& pa0, bf16x8& pa1, bf16x8& pa2, bf16x8& pa3) {
#define PK4(P, B_, OUT) do { unsigned a0 = cvt_pk_bf16(P[B_+0], P[B_+1]), a1 = cvt_pk_bf16(P[B_+2], P[B_+3]); \
        unsigned b0 = cvt_pk_bf16(P[B_+4], P[B_+5]), b1 = cvt_pk_bf16(P[B_+6], P[B_+7]); \
        auto r0 = __builtin_amdgcn_permlane32_swap(a0, b0, false, false); auto r1 = __builtin_amdgcn_permlane32_swap(a1, b1, false, false); \
        u32x4 w = {r0[0], r1[0], r0[1], r1[1]}; OUT = __builtin_bit_cast(bf16x8, w); } while (0)
    PK4(p0, 0, pa0); PK4(p0, 8, pa1); PK4(p1, 0, pa2); PK4(p1, 8, pa3);
#undef PK4
}
__device__ __forceinline__ float half_swap_max(float v) { auto rr = __builtin_amdgcn_permlane32_swap(__float_as_uint(v), __float_as_uint(v), false, false); return fmaxf(__uint_as_float(rr[0]), __uint_as_float(rr[1])); }
__device__ __forceinline__ float half_swap_sum(float v) { auto rr = __builtin_amdgcn_permlane32_swap(__float_as_uint(v), __float_as_uint(v), false, false); return __uint_as_float(rr[0]) + __uint_as_float(rr[1]); }

struct TileStage { bf16x8 k0, k1, v0, v1; };
__device__ __forceinline__ void tile_load(TileStage& T, const bf16_t* Kp, const bf16_t* Vp, int key0, int sr, int sc) {
    T.k0 = *(const bf16x8*)(Kp + (size_t)(key0 + sr) * HD + sc); T.k1 = *(const bf16x8*)(Kp + (size_t)(key0 + 32 + sr) * HD + sc);
    T.v0 = *(const bf16x8*)(Vp + (size_t)(key0 + sr) * HD + sc); T.v1 = *(const bf16x8*)(Vp + (size_t)(key0 + 32 + sr) * HD + sc);
}
__device__ __forceinline__ void tile_write(const TileStage& T, LAS unsigned char* lds, int kbuf, int vbuf, int sr, int sc) {
    const int kws = KSWZ(sr, sc * 2);
    *(LAS bf16x8*)(lds + AT_K + kbuf * SHM_T + kws) = T.k0; *(LAS bf16x8*)(lds + AT_K + kbuf * SHM_T + kws + 32 * 256) = T.k1;
    *(LAS bf16x8*)(lds + AT_V + vbuf * SHM_T + v_st(sr, sc)) = T.v0; *(LAS bf16x8*)(lds + AT_V + vbuf * SHM_T + v_st(32 + sr, sc)) = T.v1;
}

template <int MODE>
__device__ __forceinline__ void attn_branch(Frame& F, const bf16_t* Kp, const bf16_t* Vp, int j_lo, int j_hi, int sb, const bf16x8* qr, unsigned smask, f32x16* o, float& l_out) {
    int tid = F.tid; asm volatile("" : "+v"(tid));
    const int lane = tid & 63, wid = F.wave, r32 = lane & 31, hi = lane >> 5, hl = wid >> 1, rh = wid & 1;
    const int sr = tid >> 4, sc = (tid & 15) * 8;
    LAS unsigned char* lds = F.lds;
    LAS float* wsf = (LAS float*)(lds + AT_WS) + wid * 64;
    const LAS float* lut = (const LAS float*)(lds + AT_LUT) + hl * 304;
    const int vb0 = (int)(uintptr_t)(lds + AT_V) + v_rd_base(lane);
    const int qpos = 64 * sb + 32 * rh + r32;
    float m_reg = -1e30f, l_reg = 0.f;
#pragma unroll
    for (int d = 0; d < 4; ++d) o[d] = f32x16{};
    const int NT = j_hi - j_lo + 1;
    TileStage T;
    { TileStage T1; tile_load(T, Kp, Vp, j_lo * 64, sr, sc); if (NT > 1) tile_load(T1, Kp, Vp, (j_lo + 1) * 64, sr, sc);
      tile_write(T, lds, 0, 0, sr, sc); if (NT > 1) tile_write(T1, lds, 1, 1, sr, sc); }
    __syncthreads();
#define SEL_INIT(j_) ((MODE == 1) ? ((((smask >> (j_)) & 1u) != 0u) ? 0.f : -__builtin_inff()) : 0.f)
    int vs = 0;
    for (int t = 0; t < NT; ++t) {
        const int j = j_lo + t;
        f32x16 C0, C1;
        qkt(C0, C1, lds + AT_K + (t & 1) * SHM_T, r32, hi, qr, SEL_INIT(j));
        const int dq = qpos - 64 * j - 4 * hi;
        if (64 * (sb - j) + 32 * rh < 176) lut_add(C0, C1, lut + (dq + 37));
        if (j == sb || (MODE == 2 && j == sb - 8)) { const float NEG = -__builtin_inff(); const unsigned W = MODE == 2 ? 512u : 0x40000000u;
#pragma unroll
            for (int r = 0; r < 16; ++r) { const int c = (r & 3) + 8 * (r >> 2);
                if ((unsigned)(dq - c) >= W) C0[r] = NEG;
                if ((unsigned)(dq - c - 32) >= W) C1[r] = NEG; } }
        float pmax = fmaxf(C0[0], C1[0]);
#pragma unroll
        for (int r = 1; r < 16; ++r) pmax = __builtin_fmaxf(__builtin_fmaxf(pmax, C0[r]), C1[r]);
        pmax = half_swap_max(pmax);
        float alpha = 1.f;
        if (!__all(pmax - m_reg <= 6.0f)) { const float mn = fmaxf(m_reg, pmax); alpha = __builtin_amdgcn_exp2f(m_reg - mn); m_reg = mn;
            if (hi == 0) wsf[r32] = alpha;
            LDS_WAIT();
#pragma unroll
            for (int d = 0; d < 4; ++d)
#pragma unroll
                for (int r = 0; r < 16; ++r) o[d][r] *= wsf[crow(r, hi)]; }
        float ps = 0.f;
#pragma unroll
        for (int r = 0; r < 16; ++r) { C0[r] = __builtin_amdgcn_exp2f(C0[r] - m_reg); C1[r] = __builtin_amdgcn_exp2f(C1[r] - m_reg); ps += C0[r] + C1[r]; }
        ps = half_swap_sum(ps);
        l_reg = l_reg * alpha + ps;
        bf16x8 pa0, pa1, pa2, pa3; pack_p(C0, C1, pa0, pa1, pa2, pa3);
        if (t + 2 < NT) tile_load(T, Kp, Vp, (j + 2) * 64, sr, sc);
        SBAR();
        pv_tile(o, vb0 + vs * SHM_T, pa0, pa1, pa2, pa3);
        if (t + 2 < NT) tile_write(T, lds, t & 1, vs == 0 ? 2 : vs - 1, sr, sc);
        __syncthreads();
        vs = vs == 2 ? 0 : vs + 1;
    }
#undef SEL_INIT
    l_out = l_reg;
}
template <int MODE>
__device__ __forceinline__ void emit_scaled(const f32x16* o, float scl, LAS float* wsf, int r32, int hi, float* ya, bf16_t* yp) {
    if (hi == 0) wsf[r32] = scl;
    int oa = (4 * hi) * DATT + r32, ob = (4 * hi) * 64 + r32;
    asm volatile("" : "+v"(oa), "+v"(ob));
    float* yb = ya + oa; bf16_t* ypb = yp + ob;
    float prev[16][4];
    if (MODE >= 1) {
#pragma unroll
        for (int r = 0; r < 16; ++r) { const float* p = yb + (size_t)((r & 3) + 8 * (r >> 2)) * DATT;
#pragma unroll
            for (int d = 0; d < 4; ++d) prev[r][d] = p[d * 32]; }
    }
    LDS_WAIT();
    float sv[16];
#pragma unroll
    for (int r = 0; r < 16; ++r) sv[r] = wsf[crow(r, hi)];
    LDS_WAIT();
#pragma unroll
    for (int r = 0; r < 16; ++r) { const int orow = (r & 3) + 8 * (r >> 2);
        float* p = yb + (size_t)orow * DATT; bf16_t* q = ypb + (size_t)orow * 64;
#pragma unroll
        for (int d = 0; d < 4; ++d) { float v = o[d][r] * sv[r];
            if (MODE >= 1) v += prev[r][d];
            if (MODE <= 1) p[d * 32] = v;
            else { const float vn = __shfl_xor(v, 1); if ((r32 & 1) == 0) *(unsigned*)(q + (d >> 1) * (256 * 64) + (d & 1) * 32) = cvt_pk_bf16(v, vn); } } }
}

__device__ __forceinline__ int rel_bucket(int n) {
    if (n < 16) return n;
    int b = 16; const int thr[15] = {19, 21, 24, 27, 31, 35, 40, 46, 52, 59, 67, 77, 87, 99, 113};
#pragma unroll
    for (int i = 0; i < 15; ++i) b += (n >= thr[i]) ? 1 : 0;
    return b;
}

__device__ __forceinline__ void attn_unit(Frame& F, int b, int g, int sb) {
    int tid = F.tid; asm volatile("" : "+v"(tid));
    const int lane = tid & 63, wid = F.wave, r32 = lane & 31, hi = lane >> 5, hl = wid >> 1, rh = wid & 1;
    const int sr = tid >> 4, sc = (tid & 15) * 8;
    unsigned char* ws = F.ws; LAS unsigned char* lds = F.lds;
    LAS float* wsf = (LAS float*)(lds + AT_WS) + wid * 64;
    LAS float* lutw = (LAS float*)(lds + AT_LUT);
    LAS float* gl = (LAS float*)(lds + AT_GL);
    LAS unsigned* selm = (LAS unsigned*)(lds + AT_SEL);
    LAS float* impS = (LAS float*)(lds + AT_IMPS);
    LAS float* impH = (LAS float*)(lds + AT_IMPH);
    const int h = g * 4 + hl, bg = b * NG + g, row = 32 * rh + r32, pos = 64 * sb + row;
    const size_t kvs = KV_STRIDE_B / 2;
    const bf16_t* kvb = (const bf16_t*)(ws + WS_KV);
    const bf16_t* Ksel = kvb + 2 * kvs + (size_t)bg * SEQ * HD; const bf16_t* Vsel = kvb + 3 * kvs + (size_t)bg * SEQ * HD;
    const bf16_t* Kwin = kvb + 4 * kvs + (size_t)bg * SEQ * HD; const bf16_t* Vwin = kvb + 5 * kvs + (size_t)bg * SEQ * HD;
    const bf16_t* Kc = (const bf16_t*)(ws + WS_KCMP) + (size_t)bg * 128 * HD; const bf16_t* Vc = (const bf16_t*)(ws + WS_VCMP) + (size_t)bg * 128 * HD;
    __syncthreads();
    for (int i = tid; i < 4 * 304; i += 512) { const int hh = i / 304, ix = i % 304; int d = ix - 96; d = d < 0 ? 0 : (d > 127 ? 127 : d);
        const float* tab = INP(16); lutw[i] = (tab[rel_bucket(d) * NH + g * 4 + hh] - tab[31 * NH + g * 4 + hh]) * LOG2E; }
    for (int i = tid; i < 768; i += 512) { const int br = i >> 8, hh = (i >> 6) & 3, rw = i & 63; gl[i] = ((const float*)(ws + WS_GATES))[(size_t)(b * SEQ + 64 * sb + rw) * 48 + br * 16 + g * 4 + hh]; }
    if (tid < 64) selm[tid] = 0u;
    bf16x8 qr[8];
    { const bf16_t* qp = (const bf16_t*)(ws + WS_Q) + ((size_t)(b * NH + h) * SEQ + pos) * HD + hi * 8;
#pragma unroll
        for (int d0 = 0; d0 < 8; ++d0) qr[d0] = *(const bf16x8*)(qp + d0 * 16); }
    { TileStage T0, T1; tile_load(T0, Kc, Vc, 0, sr, sc); tile_load(T1, Kc, Vc, 64, sr, sc); tile_write(T0, lds, 0, 0, sr, sc); tile_write(T1, lds, 1, 1, sr, sc); }
    __syncthreads();
    f32x16 o[4];
    float* ya = (float*)(ws + WS_HID) + (size_t)(b * SEQ + 64 * sb + 32 * rh) * DATT + h * HD;
    bf16_t* yp = (bf16_t*)(ws + WS_YMIX) + blk_off(b * SEQ + 64 * sb + 32 * rh, h * HD, KT4);
    {
        f32x16 cA0, cA1, cB0, cB1;
        qkt(cA0, cA1, lds + AT_K, r32, hi, qr, 0.f);
        qkt(cB0, cB1, lds + AT_K + SHM_T, r32, hi, qr, 0.f);
        const LAS float* lut = lutw + hl * 304;
        const int dqc = pos - 31 - 64 * hi; const float NEG = -__builtin_inff();
        float mx = NEG;
#define CMP_FIX(P, CB) do { _Pragma("unroll") for (int r = 0; r < 16; ++r) { const int c = (CB) + (r & 3) + 8 * (r >> 2); const int dist = dqc - 16 * c; \
            int ix = dist + 96; ix = ix < 0 ? 0 : (ix > 303 ? 303 : ix); const float bv = lut[ix]; P[r] = dist >= 0 ? P[r] + bv : NEG; mx = fmaxf(mx, P[r]); } } while (0)
        CMP_FIX(cA0, 0); CMP_FIX(cA1, 32); CMP_FIX(cB0, 64); CMP_FIX(cB1, 96);
#undef CMP_FIX
        mx = half_swap_max(mx);
        const float mref = (mx == NEG) ? 0.f : mx;
        float ls = 0.f;
#pragma unroll
        for (int r = 0; r < 16; ++r) { cA0[r] = __builtin_amdgcn_exp2f(cA0[r] - mref); cA1[r] = __builtin_amdgcn_exp2f(cA1[r] - mref); cB0[r] = __builtin_amdgcn_exp2f(cB0[r] - mref); cB1[r] = __builtin_amdgcn_exp2f(cB1[r] - mref);
            ls += (cA0[r] + cA1[r]) + (cB0[r] + cB1[r]); }
        ls = half_swap_sum(ls);
        const float inv = ls > 0.f ? 1.0f / ls : 0.f;
#pragma unroll
        for (int r = 0; r < 16; ++r) { cA0[r] *= inv; cA1[r] *= inv; cB0[r] *= inv; cB1[r] *= inv; }
        LAS float* ih = impH + (hl * 64 + row) * 33;
        float lprev = 0.f;
#define IMP_Q(P, QB) do { _Pragma("unroll") for (int i = 0; i < 4; ++i) { const float Gq = (P[4 * i] + P[4 * i + 1]) + (P[4 * i + 2] + P[4 * i + 3]); const float Lq = P[4 * i + 3]; \
            auto rr = __builtin_amdgcn_permlane32_swap(__float_as_uint(Lq), __float_as_uint(Lq), false, false); \
            const float lp_lo = __uint_as_float(rr[0]), lp_hi = __uint_as_float(rr[1]); \
            ih[2 * ((QB) + i) + hi] = Gq + (hi ? lp_lo : lprev); lprev = lp_hi; } } while (0)
        IMP_Q(cA0, 0); IMP_Q(cA1, 4); IMP_Q(cB0, 8); IMP_Q(cB1, 12);
#undef IMP_Q
#pragma unroll
        for (int d = 0; d < 4; ++d) o[d] = f32x16{};
        const int vb0 = (int)(uintptr_t)(lds + AT_V) + v_rd_base(lane);
        { bf16x8 pa0, pa1, pa2, pa3; pack_p(cA0, cA1, pa0, pa1, pa2, pa3); SBAR(); pv_tile(o, vb0, pa0, pa1, pa2, pa3); }
        { bf16x8 pa0, pa1, pa2, pa3; pack_p(cB0, cB1, pa0, pa1, pa2, pa3); SBAR(); pv_tile(o, vb0 + SHM_T, pa0, pa1, pa2, pa3); }
        emit_scaled<0>(o, gl[0 * 256 + hl * 64 + row], wsf, r32, hi, ya, yp);
    }
    __syncthreads();
    {
        const int rw = tid >> 3, jg = tid & 7;
#pragma unroll
        for (int e = 0; e < 4; ++e) { const int j = 4 * jg + e; impS[rw * 33 + j] = (impH[(0 * 64 + rw) * 33 + j] + impH[(1 * 64 + rw) * 33 + j]) + (impH[(2 * 64 + rw) * 33 + j] + impH[(3 * 64 + rw) * 33 + j]); }
        __syncthreads();
        unsigned bits = 0u;
        if (sb <= 7) {
#pragma unroll
            for (int e = 0; e < 4; ++e) { const int j = 4 * jg + e; if (j <= sb) bits |= 1u << j; }
        } else {
            float v[32];
#pragma unroll
            for (int i = 0; i < 32; ++i) v[i] = impS[rw * 33 + i];
#pragma unroll
            for (int e = 0; e < 4; ++e) { const int j = 4 * jg + e; float vj = 0.f;
#pragma unroll
                for (int i = 0; i < 32; ++i) vj = (i == j) ? v[i] : vj;
                int rank = 0;
#pragma unroll
                for (int i = 1; i < 32; ++i) { const bool cand = i <= sb - 2; rank += (cand && (v[i] > vj || (v[i] == vj && i < j))) ? 1 : 0; }
                const bool candj = j >= 1 && j <= sb - 2;
                if ((candj && rank < 5) || j == 0 || j == sb || j == sb - 1) bits |= 1u << j; }
        }
        bits |= __shfl_xor(bits, 1); bits |= __shfl_xor(bits, 2); bits |= __shfl_xor(bits, 4);
        if (jg == 0) selm[rw] = bits;
    }
    __syncthreads();
    const unsigned smask = selm[row];
    float l2;
    attn_branch<1>(F, Ksel, Vsel, 0, sb, sb, qr, smask, o, l2);
    emit_scaled<1>(o, gl[1 * 256 + hl * 64 + row] / l2, wsf, r32, hi, ya, yp);
    float l3;
    attn_branch<2>(F, Kwin, Vwin, sb >= 8 ? sb - 8 : 0, sb, sb, qr, 0u, o, l3);
    emit_scaled<2>(o, gl[2 * 256 + hl * 64 + row] / l3, wsf, r32, hi, ya, yp);
}

constexpr int PER_PHASE = 10;
constexpr int N_LAUNCHES = MK_N_LAUNCHES;
struct Args { const float* in[22]; float* out; unsigned char* ws; int ph_lo, ph_hi, li, pad; };
__global__ void __launch_bounds__(512, 2) mk_fwd(Args args) {
    extern __shared__ __attribute__((aligned(16))) unsigned char lds_raw[];
    Frame F;
    F.lds = (LAS unsigned char*)lds_raw;
    F.tid = threadIdx.x; F.wave = __builtin_amdgcn_readfirstlane(F.tid >> 6);
    F.G = gridDim.x; { const int bx = blockIdx.x; F.vcu = (F.G % 8 == 0) ? (bx % 8) * (F.G / 8) + bx / 8 : bx; }
    F.out = args.out; F.ws = args.ws;
    unsigned char* ws = args.ws;
    volatile LAS unsigned* MISC = (volatile LAS unsigned*)(F.lds + MISC_OFF);
    for (int u = F.tid; u < (LDS_BYTES - CTRL_OFF) / 4; u += 512) ((LAS unsigned*)(F.lds + CTRL_OFF))[u] = 0u;
    __syncthreads();
    if (F.tid < 22) *(LAS u64*)(F.lds + PTR_OFF + 8 * F.tid) = (u64)(uintptr_t)args.in[F.tid];
    __syncthreads();
    unsigned* ctl = (unsigned*)(ws + WS_CTL);
    XcdBarrier bar; bar.bar = ctl + CW_BAR + args.li * XCD_BAR_WORDS; bar.x = 0; bar.st = nullptr;
    if (N_LAUNCHES != PER_PHASE) bar = xcd_barrier_post(ctl + CW_BAR + args.li * XCD_BAR_WORDS, MISC + 8);
    const int lo = args.ph_lo, hi = args.ph_hi;
#ifndef PH_MASK
#define PH_MASK 0x3ff
#endif
#define IN(k) (((PH_MASK >> (k)) & 1) && lo <= (k) && (k) < hi)
#define BOTH(k) (IN(k) && IN((k) + 1))
#define GRID_BAR() do { if (N_LAUNCHES != PER_PHASE) xcd_barrier(bar); } while (0)
    u64* racc1 = (u64*)(ws + WS_CTL + CTL_RACC); u64* racc2 = racc1 + M; u64* racc3 = racc2 + M;
    bf16_t* actb = (bf16_t*)(ws + WS_ACTB); bf16_t* hid = (bf16_t*)(ws + WS_HID);

    static_assert(N_LAUNCHES == 1, "phases 0 and 6 contain an in-phase grid barrier");
    if (IN(0)) { gu_absmax<ROT2>(F, GU_STRIPS, GU_STRIPS_ALL); gu_absmax<ROT1>(F, GU_STRIPS_ALL, GU_STRIPS_ALL + 1408); gu_absmax<0>(F, 2752, GU_STRIPS); GRID_BAR(); p0_prologue(F); if (BOTH(0)) GRID_BAR(); }

    if (IN(1)) {
        pg8::Gemm g{ws + WS_XQ, ws + WS_WGU1, DM, 1}; pg8::StaticOrder S; S.init(M, NGU, F.G, (int)blockIdx.x);
        EpiSwiGLUQ<false> E{hid, (const float*)(ws + WS_SMALL + SM_RA0), (const float*)(ws + WS_SMALL + SM_SB1), nullptr};
        pg8::gemm_phase<EpiSwiGLUQ<false>, pg8::StaticOrder, true>(F.lds, g, S, E);
        { const int r = S.nwg % F.G;
          if ((int)blockIdx.x == r && F.tid < 256) { const int kv = F.tid >> 7, n = F.tid & 127; const float* pb = (const float*)(ws + WS_SMALL + SM_PBP) + (size_t)kv * 128 * 128 + n;
              float sacc = 0.f; for (int ch = 0; ch < 128; ++ch) sacc += pb[ch * 128];
              ((float*)(ws + WS_CTL + CTL_PBSUM))[kv * 128 + n] = sacc; } }
        tail_quant<ROT1>(F, S.nwg, Q_R_D1Q + 5408, Q_R_D1Q + P0_I_D);
        GRID_BAR();
        quant_hid_rot<ROT1>(F, hid, ws + WS_HIDQ, (float*)(ws + WS_SMALL + SM_SH));
        if (BOTH(1)) GRID_BAR();
    }
    if (IN(2)) {
        pg8::Gemm g{ws + WS_HIDQ, ws + WS_WD1, FF, 1}; pg8::StaticOrder S; S.init(M, DM, F.G, (int)blockIdx.x);
        EpiResidQ E{INP(0), F.out, racc1, (const float*)(ws + WS_SMALL + SM_SH), (const float*)(ws + WS_SMALL + SM_SB4), 0.5f, actb};
        pg8::gemm_phase<EpiResidQ, pg8::StaticOrder, true>(F.lds, g, S, E);
        if (BOTH(2)) GRID_BAR();
    }
    if (IN(3)) {
        pg8::Gemm g{actb, ws + WS_WIN, DM, 2}; pg8::StaticOrder S; S.init(M, NINP, F.G, (int)blockIdx.x);
        EpiWin E{(bf16_t*)(ws + WS_Q), (bf16_t*)(ws + WS_KV), (float*)(ws + WS_U), (float*)(ws + WS_GATES), racc1, KV_STRIDE_B / 2};
        pg8::gemm_phase(F.lds, g, S, E);
        tail_convert(F, S.nwg, P0_R_OUT, P0_R_SMALL);
        tail_quant<ROT2>(F, S.nwg, Q_R_D2 + 1708, Q_R_D2 + 5408);
        tail_quant(F, S.nwg, P0_R_GU2, P0_R_GU2 + 7500);
        if (PROBE_DUP == 3) { GRID_BAR(); pg8::gemm_phase(F.lds, g, S, E); }
        if (BOTH(3)) GRID_BAR();
    }
    if (IN(4)) {
        for (int u = blockIdx.x; u < 128; u += F.G) compress_unit(F, u >> 6, u & 63);
        for (int u = blockIdx.x; u < 256; u += F.G) pool_d_unit(F, u);
        __syncthreads();
        if (F.G > 128) { if ((int)blockIdx.x >= 128) gu_quant(F, P0_R_GU2 + 7500, P0_R_D1, (int)blockIdx.x - 128, F.G - 128); }
        else gu_quant(F, P0_R_GU2 + 7500, P0_R_D1, (int)blockIdx.x, F.G);
        if (PROBE_DUP == 4) { GRID_BAR(); for (int u = blockIdx.x; u < 128; u += F.G) compress_unit(F, u >> 6, u & 63); for (int u = blockIdx.x; u < 256; u += F.G) pool_d_unit(F, u); }
        if (BOTH(4)) GRID_BAR();
    }
    if (IN(5)) {
        { pg8::Gemm g{ws + WS_DPOOL, ws + WS_SMALL + SM_WPOOL, 512, 2}; pg8::PoolOrder S{F.G, (int)blockIdx.x};
          EpiPool E{(bf16_t*)(ws + WS_YMIX), INP(14)};
          pg8::gemm_phase(F.lds, g, S, E); }
        for (int u = blockIdx.x; u < 256; u += F.G) {
            const int x = u & 7, k = u >> 3, bg = 2 * x + (k & 1), pr = k >> 1;
            attn_unit(F, bg >> 2, bg & 3, 31 - pr);
            attn_unit(F, bg >> 2, bg & 3, pr);
        }
        if (PROBE_DUP == 5) { GRID_BAR(); for (int u = blockIdx.x; u < 256; u += F.G) { const int x = u & 7, k = u >> 3, bg = 2 * x + (k & 1), pr = k >> 1; attn_unit(F, bg >> 2, bg & 3, 31 - pr); attn_unit(F, bg >> 2, bg & 3, pr); } }
        if (BOTH(5)) GRID_BAR();
    }
    if (IN(6)) {
        pg8::Gemm g{ws + WS_YMIX, ws + WS_WOUT, DM, 2}; pg8::StaticOrder S; S.init(M, DM, F.G, (int)blockIdx.x);
        EpiResid E{F.out, F.out, nullptr, nullptr, 1.0f};
        pg8::gemm_phase(F.lds, g, S, E);
        GRID_BAR();
        quant_rows(F, F.out, ws + WS_XQ, (float*)(ws + WS_SMALL + SM_RA2));
        if (BOTH(6)) GRID_BAR();
    }
    if (IN(7)) {
        pg8::Gemm g{ws + WS_XQ, ws + WS_WGU2, DM, 1}; pg8::StaticOrder S; S.init(M, NGU, F.G, (int)blockIdx.x);
        EpiSwiGLUQ<false> E{hid, (const float*)(ws + WS_SMALL + SM_RA2), (const float*)(ws + WS_SMALL + SM_SB2), nullptr};
        pg8::gemm_phase<EpiSwiGLUQ<false>, pg8::StaticOrder, true>(F.lds, g, S, E);
        tail_quant<ROT2>(F, S.nwg, Q_R_D2 + 5408, Q_R_D2 + P0_I_D);
        GRID_BAR();
        quant_hid_rot<ROT2>(F, hid, ws + WS_HIDQ, (float*)(ws + WS_SMALL + SM_SH));
        if (BOTH(7)) GRID_BAR();
    }
    if (IN(8)) {
        pg8::Gemm g{ws + WS_HIDQ, ws + WS_WD2, FF, 1}; pg8::StaticOrder S; S.init(M, DM, F.G, (int)blockIdx.x);
        EpiResidQ E{F.out, nullptr, racc3, (const float*)(ws + WS_SMALL + SM_SH), (const float*)(ws + WS_SMALL + SM_SB3), 0.5f, actb};
        pg8::gemm_phase<EpiResidQ, pg8::StaticOrder, true>(F.lds, g, S, E);
        if (BOTH(8)) GRID_BAR();
    }
    if (IN(9)) {
        const int gw = F.vcu * 8 + F.wave, NGW = F.G * 8, lane = (F.tid & 63), kq = lane >> 3, c = lane & 7;
        const float* gn = INP(21);
        for (int m = gw; m < M; m += NGW) {
            const float r = rs_from_acc(racc3[m]);
            const bf16_t* src = actb + blk_off(m, 64 * kq, KT4) + 8 * c;
            u32x4 v[8];
#pragma unroll
            for (int j = 0; j < 8; ++j) v[j] = *(const u32x4*)(src + (size_t)(8 * j) * (256 * 64));
#pragma unroll
            for (int j = 0; j < 8; ++j) {
                const int k = 64 * (8 * j + kq) + 8 * c;
                const f32x4 g0 = *(const f32x4*)(gn + k), g1 = *(const f32x4*)(gn + k + 4);
                f32x4 o0, o1;
                o0[0] = __uint_as_float(v[j].x << 16); o0[1] = __uint_as_float(v[j].x & 0xffff0000u); o0[2] = __uint_as_float(v[j].y << 16); o0[3] = __uint_as_float(v[j].y & 0xffff0000u);
                o1[0] = __uint_as_float(v[j].z << 16); o1[1] = __uint_as_float(v[j].z & 0xffff0000u); o1[2] = __uint_as_float(v[j].w << 16); o1[3] = __uint_as_float(v[j].w & 0xffff0000u);
                float* dst = F.out + (size_t)m * DM + k;
                *(f32x4*)dst = o0 * r * g0; *(f32x4*)(dst + 4) = o1 * r * g1;
            }
        }
    }
#undef IN
#undef BOTH
#undef GRID_BAR
}

extern "C" void kernel_launch(void* const* d_in, const int* in_sizes, int n_in, void* d_out, int out_size, void* d_ws, size_t ws_size, hipStream_t stream) {
    static int grid = 0;
    if (grid == 0) {
        if (n_in != 22 || in_sizes[0] != M * DM || out_size != M * DM || ws_size < WS_END3) { fprintf(stderr, "kernel_launch: unexpected shapes (n_in %d, in0 %d, out %d, ws %zu < %zu); nothing launched\n", n_in, n_in > 0 ? in_sizes[0] : -1, out_size, ws_size, (size_t)WS_END3); grid = -1; return; }
        int dev = 0, cus = 0, per_cu = 0;
        if (hipGetDevice(&dev) != hipSuccess || hipDeviceGetAttribute(&cus, hipDeviceAttributeMultiprocessorCount, dev) != hipSuccess) { grid = -1; return; }
        if (hipFuncSetAttribute((const void*)mk_fwd, hipFuncAttributeMaxDynamicSharedMemorySize, LDS_BYTES) != hipSuccess) { fprintf(stderr, "kernel_launch: hipFuncSetAttribute failed\n"); grid = -1; return; }
        if (hipOccupancyMaxActiveBlocksPerMultiprocessor(&per_cu, (const void*)mk_fwd, 512, LDS_BYTES) != hipSuccess || per_cu < 1) fprintf(stderr, "kernel_launch: occupancy query says %d\n", per_cu);
        (void)hipGetLastError();
        grid = cus;
    }
    if (grid < 0) return;
    if (hipMemsetAsync((char*)d_ws + WS_CTL, 0, CTL_ZERO_BYTES, stream) != hipSuccess) { fprintf(stderr, "kernel_launch: memset failed\n"); return; }
    Args a{};
    for (int i = 0; i < 22; ++i) a.in[i] = (const float*)d_in[i];
    a.out = (float*)d_out; a.ws = (unsigned char*)d_ws;
    for (int li = 0; li < N_LAUNCHES; ++li) {
        if (N_LAUNCHES == PER_PHASE) { a.ph_lo = li; a.ph_hi = li + 1; a.li = 0; }
        else { a.ph_lo = li * PER_PHASE / N_LAUNCHES; a.ph_hi = (li + 1) * PER_PHASE / N_LAUNCHES; a.li = li; }
        hipLaunchKernelGGL(mk_fwd, dim3(grid), dim3(512), LDS_BYTES, stream, a);
        const hipError_t le = hipPeekAtLastError();
        if (le != hipSuccess) { fprintf(stderr, "kernel_launch: launch %d failed: %s\n", li, hipGetErrorName(le)); break; }
    }
}
```

```cpp
#include <hip/hip_runtime.h>
#include <cstdio>
#include <cstdint>

#ifndef MK_N_LAUNCHES
#define MK_N_LAUNCHES 1
#endif
#ifndef PROBE_DUP
#define PROBE_DUP -1
#endif

#define LAS __attribute__((address_space(3)))
#define GAS __attribute__((address_space(1)))
typedef unsigned short bf16_t;
typedef short bf16x8 __attribute__((ext_vector_type(8)));
typedef short s16x4 __attribute__((ext_vector_type(4)));
typedef float f32x4 __attribute__((ext_vector_type(4)));
typedef float f32x16 __attribute__((ext_vector_type(16)));
typedef unsigned u32x4 __attribute__((ext_vector_type(4)));
typedef unsigned u32x2 __attribute__((ext_vector_type(2)));
typedef int i32x4 __attribute__((ext_vector_type(4)));
typedef unsigned long long u64;

constexpr int BATCH = 4, SEQ = 2048, DM = 4096, FF = 11008, NGU = 2 * FF, M = BATCH * SEQ;
constexpr int NH = 16, NG = 4, HD = 128, DATT = 2048, DKV = 512, DPOOL = 2048;
__host__ __device__ __forceinline__ size_t blk_off(int r, int k, int KT) { return ((size_t)((r >> 8) * KT + (k >> 6)) * 256 + (size_t)(r & 255)) * 64 + (size_t)(k & 63); }
constexpr int KT4 = DM / 64, KTF = FF / 64, KTP = 512 / 64;
__host__ __device__ __forceinline__ size_t blk8_off(int r, int k, int KT8_) { return ((size_t)((r >> 8) * KT8_ + (k >> 7)) * 256 + (size_t)(r & 255)) * 128 + (size_t)(k & 127); }
constexpr int KT8 = DM / 128;
constexpr int NIN = 7216, NINP = 7424;
constexpr float EPS = 1e-6f;
constexpr float LOG2E = 1.4426950408889634f;
constexpr float QSCALE = 0.08838834764831845f * LOG2E;

__device__ __forceinline__ unsigned cvt_pk_bf16(float lo, float hi) { unsigned r; asm volatile("v_cvt_pk_bf16_f32 %0, %1, %2" : "=v"(r) : "v"(lo), "v"(hi)); return r; }
__device__ __forceinline__ float rs_from_acc(u64 a) { return __builtin_amdgcn_rsqf((float)a * (1.0f / (4294967296.0f * 4096.0f)) + EPS); }

namespace pg8 {
constexpr int BM = 256, BK = 64, HALF = 128, HTB = HALF * BK * 2, STAGE_BYTES = 8 * HTB, NXCD = 8, WGM = 4;
__host__ __device__ __forceinline__ int lds_byte(int r, int c) { const int st = (r >> 4) * 2 + (c >> 5), rr = r & 15, cc = c & 31, ob = rr * 64 + cc * 2; return st * 1024 + (ob ^ (((ob >> 9) & 1) << 5)); }
__host__ __device__ __forceinline__ void stage_rc(int b, int& R, int& C) { const int st = b / 1024, sb = b % 1024, swz = sb ^ (((sb >> 9) & 1) << 5); R = (st >> 1) * 16 + swz / 64; C = (st & 1) * 32 + (swz % 64) / 2; }
__host__ __device__ __forceinline__ int perm32(int rho) { const int n = rho >> 4, i = rho & 15; return 8 * (i >> 2) + 4 * n + (i & 3); }

struct Unit { int pm, pn, g; };
struct Gemm { const void* A; const void* Bt; int K, esz; };

struct StaticOrder {
    int nM, nN, nwg, G, c;
    __device__ void init(int M_, int N_, int G_, int c_) { nM = M_ / BM; nN = N_ / BM; nwg = nM * nN; G = G_; c = c_; }
    __device__ bool next(int i, Unit& u) const {
        const long L = (long)i * G + c; if (L >= nwg) return false;
        int wgid = (int)L; { const int q = nwg / NXCD, r = nwg % NXCD, xcd = wgid % NXCD, off = wgid / NXCD; wgid = (xcd < r ? xcd * (q + 1) : r * (q + 1) + (xcd - r) * q) + off; }
        const int nig = WGM * nN, gid = wgid / nig, fm = gid * WGM, gsz = (nM - fm) < WGM ? (nM - fm) : WGM;
        u.pm = fm + ((wgid % nig) % gsz); u.pn = (wgid % nig) / gsz; u.g = 0; return true;
    }
    __device__ __forceinline__ size_t aoff(const Unit& u, const Gemm& g) const { return (size_t)u.pm * BM * g.K * g.esz; }
    __device__ __forceinline__ size_t boff(const Unit& u, const Gemm& g) const { return (size_t)u.pn * BM * g.K * g.esz; }
};
struct PoolOrder {
    int G, c;
    __device__ bool next(int i, Unit& u) const { const int L = i * G + c; if (L >= 256) return false; u.g = L >> 6; const int r = L & 63; u.pm = r >> 1; u.pn = r & 1; return true; }
    __device__ __forceinline__ size_t aoff(const Unit& u, const Gemm& g) const { return (size_t)(u.g * 32 + u.pm) * BM * g.K * g.esz; }
    __device__ __forceinline__ size_t boff(const Unit& u, const Gemm& g) const { return (size_t)(u.g * 2 + u.pn) * BM * g.K * g.esz; }
};

template <class Epi, class Sched, bool I8 = false>
__device__ __forceinline__ void gemm_phase(LAS unsigned char* lds, const Gemm g, const Sched& S, const Epi& E) {
    const int tid = threadIdx.x, wid = __builtin_amdgcn_readfirstlane(tid >> 6), lane = tid & 63, wr = wid >> 2, wc = wid & 3, fr = lane & 15, fq = lane >> 4;
    const int nt = g.K * g.esz / (BK * 2);
    unsigned voffA[2], voffB[2];
#pragma unroll
    for (int i = 0; i < 2; ++i) { int R, C; stage_rc(tid * 16 + i * 8192, R, C); const int Rb = Epi::PERM ? ((R & ~31) + perm32(R & 31)) : R;
        voffA[i] = (unsigned)(R * 64 + C) * 2u; voffB[i] = (unsigned)(Rb * 64 + C) * 2u; }
    const size_t kstep = (size_t)(BM * BK * 2);
    const size_t hstepA = (size_t)HALF * BK * 2, hstepB = (size_t)HALF * BK * 2;
    const unsigned ldsw = (unsigned)wid * 1024u;
    const int aoff = lds_byte(wr * 64 + fr, fq * 8), boff = lds_byte(wc * 32 + fr, fq * 8);
#define PG8_SA(b, h) (((b) * 2 + (h)) * HTB)
#define PG8_SB(b, h) ((4 + (b) * 2 + (h)) * HTB)
#define PG8_STAGE(bufoff, gbase, voff) do { _Pragma("unroll") for (int _i = 0; _i < 2; ++_i) \
        __builtin_amdgcn_global_load_lds((const unsigned*)((const char*)(gbase) + (voff)[_i]), (LAS unsigned*)(lds + (bufoff) + ldsw + _i * 8192), 16, 0, 0); } while (0)
#define PG8_LDA(dst, b, h) do { _Pragma("unroll") for (int m = 0; m < 4; ++m) _Pragma("unroll") for (int k = 0; k < 2; ++k) dst[m][k] = *(const LAS bf16x8*)(lds + PG8_SA(b, h) + aoff + m * 2048 + k * 1024); } while (0)
#define PG8_LDB(dst, b, h) do { _Pragma("unroll") for (int n = 0; n < 2; ++n) _Pragma("unroll") for (int k = 0; k < 2; ++k) dst[n][k] = *(const LAS bf16x8*)(lds + PG8_SB(b, h) + boff + n * 2048 + k * 1024); } while (0)
#define PG8_MMA(ai, bj, At, Bt) do { __builtin_amdgcn_s_setprio(1); _Pragma("unroll") for (int m = 0; m < 4; ++m) _Pragma("unroll") for (int n = 0; n < 2; ++n) _Pragma("unroll") for (int k = 0; k < 2; ++k) { \
        if constexpr (I8) acc[ai][bj][m][n] = __builtin_bit_cast(acc_t, __builtin_amdgcn_mfma_i32_16x16x64_i8(__builtin_bit_cast(i32x4, Bt[n][k]), __builtin_bit_cast(i32x4, At[m][k]), __builtin_bit_cast(i32x4, acc[ai][bj][m][n]), 0, 0, 0)); \
        else acc[ai][bj][m][n] = __builtin_bit_cast(acc_t, __builtin_amdgcn_mfma_f32_16x16x32_bf16(Bt[n][k], At[m][k], __builtin_bit_cast(f32x4, acc[ai][bj][m][n]), 0, 0, 0)); } __builtin_amdgcn_s_setprio(0); } while (0)
#define PG8_WAIT_V(n) asm volatile("s_waitcnt vmcnt(" #n ")" ::: "memory")
#define PG8_WAIT_L(n) asm volatile("s_waitcnt lgkmcnt(" #n ")" ::: "memory")
#define PG8_BAR __builtin_amdgcn_s_barrier()
#define PG8_SCHED __builtin_amdgcn_sched_barrier(0)
    Unit cur, nxt; int ui = 0;
    if (!S.next(0, cur)) return;
    typedef typename Epi::acc_t acc_t;
    acc_t acc[2][2][4][2];
#pragma unroll
    for (int a = 0; a < 2; ++a)
#pragma unroll
        for (int b = 0; b < 2; ++b)
#pragma unroll
            for (int m = 0; m < 4; ++m)
#pragma unroll
                for (int n = 0; n < 2; ++n) acc[a][b][m][n] = acc_t{};
    bf16x8 At[4][2], B0[2][2], B1[2][2];
    const char* cA = (const char*)g.A + S.aoff(cur, g); const char* cB = (const char*)g.Bt + S.boff(cur, g);
    PG8_STAGE(PG8_SB(0, 0), cB, voffB); PG8_STAGE(PG8_SB(0, 1), cB + hstepB, voffB); PG8_STAGE(PG8_SA(0, 0), cA, voffA); PG8_STAGE(PG8_SA(0, 1), cA + hstepA, voffA);
    if (wr == 1) PG8_BAR;
    PG8_WAIT_V(2); PG8_BAR;
    PG8_STAGE(PG8_SB(1, 0), cB + kstep, voffB); PG8_STAGE(PG8_SA(1, 0), cA + kstep, voffA); PG8_STAGE(PG8_SB(1, 1), cB + hstepB + kstep, voffB);
    PG8_WAIT_V(6); PG8_BAR;
    for (;;) {
        const bool has_next = S.next(ui + 1, nxt);
        const char* nA = has_next ? (const char*)g.A + S.aoff(nxt, g) : cA; const char* nB = has_next ? (const char*)g.Bt + S.boff(nxt, g) : cB;
        for (int t = 0; t < nt; t += 2) {
            const bool last = (t == nt - 2);
            const char* a1 = cA + (size_t)(t + 1) * kstep;
            const char* a2 = last ? nA : cA + (size_t)(t + 2) * kstep; const char* b2 = last ? nB : cB + (size_t)(t + 2) * kstep;
            const char* a3 = a2 + kstep; const char* b3 = b2 + kstep;
            PG8_LDB(B0, 0, 0); PG8_LDB(B1, 0, 1); PG8_SCHED; PG8_LDA(At, 0, 0); PG8_STAGE(PG8_SA(1, 1), a1 + hstepA, voffA);
            PG8_WAIT_V(8); PG8_WAIT_L(0); PG8_BAR; PG8_MMA(0, 0, At, B0); PG8_MMA(0, 1, At, B1); PG8_BAR; PG8_SCHED;
            PG8_LDA(At, 0, 1); PG8_STAGE(PG8_SB(0, 0), b2, voffB); PG8_STAGE(PG8_SB(0, 1), b2 + hstepB, voffB); PG8_STAGE(PG8_SA(0, 0), a2, voffA);
            PG8_WAIT_V(8); PG8_WAIT_L(0); PG8_BAR; PG8_MMA(1, 0, At, B0); PG8_MMA(1, 1, At, B1); PG8_BAR; PG8_SCHED;
            PG8_LDB(B0, 1, 0); PG8_LDB(B1, 1, 1); PG8_SCHED; PG8_LDA(At, 1, 0); PG8_STAGE(PG8_SA(0, 1), a2 + hstepA, voffA);
            PG8_WAIT_V(8); PG8_WAIT_L(0); PG8_BAR; PG8_MMA(0, 0, At, B0); PG8_MMA(0, 1, At, B1); PG8_BAR; PG8_SCHED;
            PG8_LDA(At, 1, 1); PG8_STAGE(PG8_SB(1, 0), b3, voffB); PG8_STAGE(PG8_SB(1, 1), b3 + hstepB, voffB); PG8_STAGE(PG8_SA(1, 0), a3, voffA);
            PG8_WAIT_V(8); PG8_WAIT_L(0); PG8_BAR; PG8_MMA(1, 0, At, B0); PG8_MMA(1, 1, At, B1); PG8_BAR; PG8_SCHED;
        }
        if (wr == 0) PG8_BAR;
        E(acc, cur, wr, wc, fr, fq);
        if (!has_next) break;
#pragma unroll
        for (int a = 0; a < 2; ++a)
#pragma unroll
            for (int b = 0; b < 2; ++b)
#pragma unroll
                for (int m = 0; m < 4; ++m)
#pragma unroll
                    for (int n = 0; n < 2; ++n) acc[a][b][m][n] = acc_t{};
        cur = nxt; cA = nA; cB = nB; ++ui;
        if (wr == 1) PG8_BAR;
    }
    PG8_WAIT_V(0);
    PG8_BAR;
#undef PG8_SA
#undef PG8_SB
#undef PG8_STAGE
#undef PG8_LDA
#undef PG8_LDB
#undef PG8_MMA
#undef PG8_WAIT_V
#undef PG8_WAIT_L
#undef PG8_BAR
#undef PG8_SCHED
}
}

__device__ __forceinline__ float silu_mul(float g, float u) { return g * u * __builtin_amdgcn_rcpf(1.0f + __builtin_amdgcn_exp2f(-g * LOG2E)); }

template <bool R64> struct EpiSwiGLU {
    static constexpr bool PERM = true; typedef f32x4 acc_t;
    bf16_t* O; const void* rs;
    __device__ __forceinline__ void operator()(const f32x4 (&acc)[2][2][4][2], const pg8::Unit& u, int wr, int wc, int fr, int fq) const {
        const int row0 = u.pm * 256 + wr * 64 + fr, col0 = u.pn * 128 + wc * 32 + 8 * fq;
        float rr[2][4];
#pragma unroll
        for (int ai = 0; ai < 2; ++ai)
#pragma unroll
            for (int m = 0; m < 4; ++m) { const int row = row0 + ai * 128 + m * 16; rr[ai][m] = R64 ? rs_from_acc(((const u64*)rs)[row]) : ((const float*)rs)[row]; }
#pragma unroll
        for (int ai = 0; ai < 2; ++ai)
#pragma unroll
            for (int m = 0; m < 4; ++m) {
                const int row = row0 + ai * 128 + m * 16;
                const float r = rr[ai][m];
                const f32x4 g0 = acc[ai][0][m][0] * r, g1 = acc[ai][0][m][1] * r, u0 = acc[ai][1][m][0] * r, u1 = acc[ai][1][m][1] * r;
                u32x4 w;
                w.x = cvt_pk_bf16(silu_mul(g0[0], u0[0]), silu_mul(g0[1], u0[1])); w.y = cvt_pk_bf16(silu_mul(g0[2], u0[2]), silu_mul(g0[3], u0[3]));
                w.z = cvt_pk_bf16(silu_mul(g1[0], u1[0]), silu_mul(g1[1], u1[1])); w.w = cvt_pk_bf16(silu_mul(g1[2], u1[2]), silu_mul(g1[3], u1[3]));
                *(u32x4*)(O + blk_off(row, col0, KTF)) = w;
            }
    }
};
__device__ __forceinline__ float bfly8(float x, bool up) { const float p = __uint_as_float(__builtin_amdgcn_update_dpp(0u, __float_as_uint(x), 0x128, 0xf, 0xf, false)); return up ? p - x : x + p; }
__device__ __forceinline__ float bfly16(float x, bool up) { const auto r = __builtin_amdgcn_permlane16_swap(__float_as_uint(x), __float_as_uint(x), false, false); const float a = __uint_as_float(r[0]), b = __uint_as_float(r[1]); return up ? a - b : a + b; }
__device__ __forceinline__ float bfly32(float x, bool up) { const auto r = __builtin_amdgcn_permlane32_swap(__float_as_uint(x), __float_as_uint(x), false, false); const float a = __uint_as_float(r[0]), b = __uint_as_float(r[1]); return up ? a - b : a + b; }
template <bool ROT>
struct EpiSwiGLUQ {
    static constexpr bool PERM = true; typedef i32x4 acc_t;
    bf16_t* O; const float* ra; const float* sb; unsigned* rmax;
    __device__ __forceinline__ void operator()(const i32x4 (&acc)[2][2][4][2], const pg8::Unit& u, int wr, int wc, int fr, int fq) const {
        const int row0 = u.pm * 256 + wr * 64 + fr, col0 = u.pn * 128 + wc * 32 + 8 * fq, ch0 = u.pn * 256 + wc * 32 + 8 * fq;
        const f32x4 sg0 = *(const f32x4*)(sb + ch0), sg1 = *(const f32x4*)(sb + ch0 + 4), su0 = *(const f32x4*)(sb + ch0 + 128), su1 = *(const f32x4*)(sb + ch0 + 132);
        float rr[2][4];
#pragma unroll
        for (int ai = 0; ai < 2; ++ai)
#pragma unroll
            for (int m = 0; m < 4; ++m) rr[ai][m] = ra[row0 + ai * 128 + m * 16];
#pragma unroll
        for (int ai = 0; ai < 2; ++ai)
#pragma unroll
            for (int m = 0; m < 4; ++m) {
                const int row = row0 + ai * 128 + m * 16; const float r = rr[ai][m];
                typedef float f32x2_t __attribute__((ext_vector_type(2)));
                const f32x2_t r2 = {r, r}, nl2 = {-LOG2E, -LOG2E}, one2 = {1.0f, 1.0f};
                float hh[8];
#pragma unroll
                for (int n = 0; n < 2; ++n)
#pragma unroll
                    for (int p = 0; p < 2; ++p) {
                        const f32x4 sgv = n ? sg1 : sg0, suv = n ? su1 : su0;
                        const f32x2_t a2 = {(float)acc[ai][0][m][n][2 * p], (float)acc[ai][0][m][n][2 * p + 1]}, b2 = {(float)acc[ai][1][m][n][2 * p], (float)acc[ai][1][m][n][2 * p + 1]};
                        const f32x2_t sg2 = {sgv[2 * p], sgv[2 * p + 1]}, su2 = {suv[2 * p], suv[2 * p + 1]};
                        const f32x2_t g2 = a2 * (r2 * sg2), u2 = b2 * (r2 * su2);
                        const f32x2_t t2 = g2 * nl2;
                        f32x2_t d2 = {__builtin_amdgcn_exp2f(t2.x), __builtin_amdgcn_exp2f(t2.y)};
                        d2 = d2 + one2;
                        d2 = (f32x2_t){__builtin_amdgcn_rcpf(d2.x), __builtin_amdgcn_rcpf(d2.y)};
                        const f32x2_t h2v = (g2 * u2) * d2;
                        hh[4 * n + 2 * p] = h2v.x; hh[4 * n + 2 * p + 1] = h2v.y;
                    }
                float h0 = hh[0], h1 = hh[1], h2 = hh[2], h3 = hh[3], h4 = hh[4], h5 = hh[5], h6 = hh[6], h7 = hh[7];
                if (ROT) {
#define FW_BF(a, b) { const float t_ = a; a = t_ + b; b = t_ - b; }
                    FW_BF(h0, h1) FW_BF(h2, h3) FW_BF(h4, h5) FW_BF(h6, h7)
                    FW_BF(h0, h2) FW_BF(h1, h3) FW_BF(h4, h6) FW_BF(h5, h7)
                    FW_BF(h0, h4) FW_BF(h1, h5) FW_BF(h2, h6) FW_BF(h3, h7)
#undef FW_BF
#define FW_X(h, L, sgn) { h = (L == 16) ? bfly16(h, sgn) : bfly32(h, sgn); }
                    { const bool s16 = (fq & 1) != 0, s32 = (fq & 2) != 0;
                      FW_X(h0, 16, s16) FW_X(h1, 16, s16) FW_X(h2, 16, s16) FW_X(h3, 16, s16) FW_X(h4, 16, s16) FW_X(h5, 16, s16) FW_X(h6, 16, s16) FW_X(h7, 16, s16)
                      FW_X(h0, 32, s32) FW_X(h1, 32, s32) FW_X(h2, 32, s32) FW_X(h3, 32, s32) FW_X(h4, 32, s32) FW_X(h5, 32, s32) FW_X(h6, 32, s32) FW_X(h7, 32, s32) }
#undef FW_X
                    const float sc = 0.17677669529663687f;
                    h0 *= sc; h1 *= sc; h2 *= sc; h3 *= sc; h4 *= sc; h5 *= sc; h6 *= sc; h7 *= sc;
                }
                u32x4 w;
                w.x = cvt_pk_bf16(h0, h1); w.y = cvt_pk_bf16(h2, h3); w.z = cvt_pk_bf16(h4, h5); w.w = cvt_pk_bf16(h6, h7);
                *(u32x4*)(O + blk_off(row, col0, KTF)) = w;
                if (rmax) {
                    unsigned mb = 0u;
#pragma unroll
                    for (int e = 0; e < 4; ++e) { const unsigned x = w[e]; const unsigned lo = (x << 16) & 0x7fff0000u, hi2 = x & 0x7fff0000u; mb = mb > lo ? mb : lo; mb = mb > hi2 ? mb : hi2; }
                    unsigned o1 = __shfl_xor(mb, 16); mb = mb > o1 ? mb : o1; o1 = __shfl_xor(mb, 32); mb = mb > o1 ? mb : o1;
                    if (fq == 0) atomicMax(rmax + row, mb);
                }
            }
    }
};
struct EpiResidQ {
    static constexpr bool PERM = true; typedef i32x4 acc_t;
    const float* res; float* out; u64* racc; const float* sh; const float* sbn; float alpha; bf16_t* ob;
    __device__ __forceinline__ void operator()(const i32x4 (&acc)[2][2][4][2], const pg8::Unit& u, int wr, int wc, int fr, int fq) const {
        int row0 = u.pm * 256 + wr * 64 + fr, col0 = u.pn * 256 + wc * 32 + 8 * fq;
        asm volatile("" : "+v"(row0), "+v"(col0));
        f32x4 s0[2], s1[2];
#pragma unroll
        for (int bj = 0; bj < 2; ++bj) { s0[bj] = *(const f32x4*)(sbn + col0 + bj * 128); s1[bj] = *(const f32x4*)(sbn + col0 + bj * 128 + 4); }
#pragma unroll
        for (int ai = 0; ai < 2; ++ai)
#pragma unroll
            for (int mh = 0; mh < 2; ++mh) {
                f32x4 pa[2][2], pb[2][2]; float rs[2];
#pragma unroll
                for (int mm = 0; mm < 2; ++mm) { const int row = row0 + ai * 128 + (2 * mh + mm) * 16; rs[mm] = sh[row] * alpha;
#pragma unroll
                    for (int bj = 0; bj < 2; ++bj) { const size_t off = (size_t)row * DM + col0 + bj * 128; pa[mm][bj] = *(const f32x4*)(res + off); pb[mm][bj] = *(const f32x4*)(res + off + 4); } }
#pragma unroll
                for (int mm = 0; mm < 2; ++mm) {
                    const int m = 2 * mh + mm, row = row0 + ai * 128 + m * 16; float ss = 0.f;
#pragma unroll
                    for (int bj = 0; bj < 2; ++bj) {
                        const size_t off = (size_t)row * DM + col0 + bj * 128; f32x4 v0, v1;
#pragma unroll
                        for (int e = 0; e < 4; ++e) { v0[e] = pa[mm][bj][e] + (float)acc[ai][bj][m][0][e] * rs[mm] * s0[bj][e]; v1[e] = pb[mm][bj][e] + (float)acc[ai][bj][m][1][e] * rs[mm] * s1[bj][e]; }
                        if (out) { *(f32x4*)(out + off) = v0; *(f32x4*)(out + off + 4) = v1; }
                        if (ob) { u32x4 w; w.x = cvt_pk_bf16(v0[0], v0[1]); w.y = cvt_pk_bf16(v0[2], v0[3]); w.z = cvt_pk_bf16(v1[0], v1[1]); w.w = cvt_pk_bf16(v1[2], v1[3]); *(u32x4*)(ob + blk_off(row, col0 + bj * 128, KT4)) = w; }
                        ss += (v0[0] * v0[0] + v0[1] * v0[1]) + (v0[2] * v0[2] + v0[3] * v0[3]) + (v1[0] * v1[0] + v1[1] * v1[1]) + (v1[2] * v1[2] + v1[3] * v1[3]);
                    }
                    ss += __shfl_xor(ss, 16); ss += __shfl_xor(ss, 32);
                    if (fq == 0 && racc) atomicAdd(racc + row, (u64)(ss * 4294967296.0f));
                }
            }
    }
};
struct EpiResid {
    static constexpr bool PERM = true; typedef f32x4 acc_t;
    const float* res; float* out; bf16_t* ob; u64* racc; float alpha;
    __device__ __forceinline__ void operator()(const f32x4 (&acc)[2][2][4][2], const pg8::Unit& u, int wr, int wc, int fr, int fq) const {
        const int row0 = u.pm * 256 + wr * 64 + fr, col0 = u.pn * 256 + wc * 32 + 8 * fq;
#pragma unroll
        for (int ai = 0; ai < 2; ++ai) {
            f32x4 pa[4][2], pb[4][2];
#pragma unroll
            for (int m = 0; m < 4; ++m)
#pragma unroll
                for (int bj = 0; bj < 2; ++bj) { const size_t off = (size_t)(row0 + ai * 128 + m * 16) * DM + col0 + bj * 128; pa[m][bj] = *(const f32x4*)(res + off); pb[m][bj] = *(const f32x4*)(res + off + 4); }
#pragma unroll
            for (int m = 0; m < 4; ++m) {
                const int row = row0 + ai * 128 + m * 16; float ss = 0.f;
#pragma unroll
                for (int bj = 0; bj < 2; ++bj) {
                    const size_t off = (size_t)row * DM + col0 + bj * 128;
                    const f32x4 v0 = pa[m][bj] + acc[ai][bj][m][0] * alpha, v1 = pb[m][bj] + acc[ai][bj][m][1] * alpha;
                    *(f32x4*)(out + off) = v0; *(f32x4*)(out + off + 4) = v1;
                    if (ob) { u32x4 w; w.x = cvt_pk_bf16(v0[0], v0[1]); w.y = cvt_pk_bf16(v0[2], v0[3]); w.z = cvt_pk_bf16(v1[0], v1[1]); w.w = cvt_pk_bf16(v1[2], v1[3]); *(u32x4*)(ob + blk_off(row, col0 + bj * 128, KT4)) = w; }
                    ss += (v0[0] * v0[0] + v0[1] * v0[1]) + (v0[2] * v0[2] + v0[3] * v0[3]) + (v1[0] * v1[0] + v1[1] * v1[1]) + (v1[2] * v1[2] + v1[3] * v1[3]);
                }
                ss += __shfl_xor(ss, 16); ss += __shfl_xor(ss, 32);
                if (fq == 0 && racc) atomicAdd(racc + row, (u64)(ss * 4294967296.0f));
            }
        }
    }
};
struct EpiWin {
    static constexpr bool PERM = true; typedef f32x4 acc_t;
    bf16_t* qb; bf16_t* kvb; float* ub; float* gb; const u64* racc; size_t kv_stride;
    __device__ __forceinline__ void operator()(const f32x4 (&acc)[2][2][4][2], const pg8::Unit& u, int wr, int wc, int fr, int fq) const {
        const int row0 = u.pm * 256 + wr * 64 + fr, pn = u.pn, cw = wc * 32 + 8 * fq;
        float rr[2][4];
#pragma unroll
        for (int ai = 0; ai < 2; ++ai)
#pragma unroll
            for (int m = 0; m < 4; ++m) rr[ai][m] = rs_from_acc(racc[row0 + ai * 128 + m * 16]);
#pragma unroll
        for (int ai = 0; ai < 2; ++ai)
#pragma unroll
            for (int m = 0; m < 4; ++m) {
                const int row = row0 + ai * 128 + m * 16, b = row >> 11, s = row & 2047;
                const float r = rr[ai][m];
#pragma unroll
                for (int bj = 0; bj < 2; ++bj) {
                    f32x4 v0 = acc[ai][bj][m][0] * r, v1 = acc[ai][bj][m][1] * r;
                    if (pn < 8) {
                        v0 = v0 * QSCALE; v1 = v1 * QSCALE; const int h = 2 * pn + bj;
                        u32x4 w; w.x = cvt_pk_bf16(v0[0], v0[1]); w.y = cvt_pk_bf16(v0[2], v0[3]); w.z = cvt_pk_bf16(v1[0], v1[1]); w.w = cvt_pk_bf16(v1[2], v1[3]);
                        *(u32x4*)(qb + ((size_t)(b * NH + h) * SEQ + s) * HD + cw) = w;
                    } else if (pn < 20) {
                        const int ti = (pn - 8) >> 1, gg = ((pn - 8) & 1) * 2 + bj;
                        u32x4 w; w.x = cvt_pk_bf16(v0[0], v0[1]); w.y = cvt_pk_bf16(v0[2], v0[3]); w.z = cvt_pk_bf16(v1[0], v1[1]); w.w = cvt_pk_bf16(v1[2], v1[3]);
                        *(u32x4*)(kvb + (size_t)ti * kv_stride + ((size_t)(b * NG + gg) * SEQ + s) * HD + cw) = w;
                    } else if (pn < 28) {
                        float* p = ub + (size_t)row * DPOOL + (pn - 20) * 256 + bj * 128 + cw;
                        *(f32x4*)p = v0; *(f32x4*)(p + 4) = v1;
                    } else {
                        if (bj == 0 && cw < 48) {
                            float* p = gb + (size_t)row * 48 + cw; f32x4 s0, s1;
#pragma unroll
                            for (int e = 0; e < 4; ++e) { s0[e] = __builtin_amdgcn_rcpf(1.0f + __builtin_amdgcn_exp2f(-v0[e] * LOG2E)); s1[e] = __builtin_amdgcn_rcpf(1.0f + __builtin_amdgcn_exp2f(-v1[e] * LOG2E)); }
                            *(f32x4*)p = s0; *(f32x4*)(p + 4) = s1;
                        }
                    }
                }
            }
    }
};
struct EpiPool {
    static constexpr bool PERM = true; typedef f32x4 acc_t;
    bf16_t* ymix; const float* pscale;
    __device__ __forceinline__ void operator()(const f32x4 (&acc)[2][2][4][2], const pg8::Unit& u, int wr, int wc, int fr, int fq) const {
        const int row0 = u.pm * 256 + wr * 64 + fr, colb = u.g * 512 + u.pn * 256 + wc * 32 + 8 * fq;
#pragma unroll
        for (int bj = 0; bj < 2; ++bj) {
            const int col = colb + bj * 128; const f32x4 s0 = *(const f32x4*)(pscale + col), s1 = *(const f32x4*)(pscale + col + 4);
#pragma unroll
            for (int ai = 0; ai < 2; ++ai)
#pragma unroll
                for (int m = 0; m < 4; ++m) {
                    const int row = row0 + ai * 128 + m * 16; const f32x4 v0 = acc[ai][bj][m][0] * s0, v1 = acc[ai][bj][m][1] * s1;
                    u32x4 w; w.x = cvt_pk_bf16(v0[0], v0[1]); w.y = cvt_pk_bf16(v0[2], v0[3]); w.z = cvt_pk_bf16(v1[0], v1[1]); w.w = cvt_pk_bf16(v1[2], v1[3]);
                    *(u32x4*)(ymix + blk_off(row, DATT + col, KT4)) = w;
                }
        }
    }
};

constexpr size_t MiB = 1u << 20;
constexpr size_t WS_CTL = 0, CTL_ZERO_BYTES = 2 * MiB;
constexpr size_t WS_WGU1 = 2 * MiB, WS_WD1 = WS_WGU1 + 172 * MiB, WS_WIN = WS_WD1 + 86 * MiB, WS_WOUT = WS_WIN + 58 * MiB;
constexpr size_t WS_WGU2 = WS_WOUT + 32 * MiB, WS_WD2 = WS_WGU2 + 172 * MiB, WS_SMALL = WS_WD2 + 86 * MiB;
constexpr size_t SM_WPOOL = 0, SM_WCK1 = 3 * MiB, SM_WCV1 = 4 * MiB, SM_WCK2 = 5 * MiB, SM_WCV2 = 5 * MiB + 65536, SM_PBP = 5 * MiB + 131072, SM_R0 = 5 * MiB + 131072 + 262144;
constexpr size_t WS_HID = WS_SMALL + 7 * MiB, WS_ACTB = WS_HID + 172 * MiB, WS_Q = WS_ACTB + 64 * MiB, WS_KV = WS_Q + 32 * MiB;
constexpr size_t KV_STRIDE_B = 8 * MiB + 65536;
constexpr size_t WS_KCMP = WS_KV + 6 * KV_STRIDE_B, WS_VCMP = WS_KCMP + 1 * MiB, WS_GATES = WS_VCMP + 1 * MiB, WS_U = WS_GATES + 2 * MiB;
constexpr size_t WS_DPOOL = WS_U + 64 * MiB, WS_YMIX = WS_DPOOL + 32 * MiB, WS_END = WS_YMIX + 64 * MiB;
constexpr size_t WS_XQ = WS_END, WS_END2 = WS_XQ + 32 * MiB;
constexpr size_t SM_SB1 = 6 * MiB, SM_SB2 = 6 * MiB + 131072, SM_RA0 = 6 * MiB + 262144, SM_RA2 = 6 * MiB + 327680;
constexpr size_t WS_HIDQ = WS_END2, WS_END3 = WS_HIDQ + 86 * MiB;
constexpr int ROT1 = 2, ROT2 = 2;
constexpr size_t SM_SB4 = 6 * MiB + 458752;
constexpr size_t SM_SB3 = 6 * MiB + 393216, SM_SH = 6 * MiB + 425984;
constexpr size_t CTL_PBSUM = 1024 * 1024;
constexpr size_t CTL_RMAX = 768 * 1024;
constexpr size_t CTL_CMAX = 512 * 1024;
constexpr int CW_BAR = 4096;
constexpr size_t CTL_RACC = 256 * 1024;
static_assert(22016ull * 4096 * 2 == 172 * MiB && 4096ull * 11008 * 2 == 86 * MiB && 7424ull * 4096 * 2 == 58 * MiB, "weight sizes");

constexpr int RING_BYTES = 131072, LDS_BYTES = 163840, CTRL_OFF = LDS_BYTES - 2048, MISC_OFF = CTRL_OFF + 320, PTR_OFF = CTRL_OFF + 1024;
#define INP(k) ((const float*)(const GAS float*)(uintptr_t)(*(const LAS u64*)(F.lds + PTR_OFF + 8 * (k))))

#define XB_TMO      128
#define XB_XCNT(j)  (256  + 64 * (j))
#define XB_XSUB(j)  (1280 + 64 * (j))
#define XB_XGEN(j)  (2304 + 64 * (j))
#define XB_TOP      3328
#define XB_TOPGEN   3392
#define XCD_BAR_WORDS 3456
#define XB_SPIN_CAP (1u << 18)
__device__ __forceinline__ unsigned xb_ld(unsigned* p)              { return __hip_atomic_load(p, __ATOMIC_RELAXED, __HIP_MEMORY_SCOPE_AGENT); }
__device__ __forceinline__ unsigned xb_add(unsigned* p, unsigned v) { return __hip_atomic_fetch_add(p, v, __ATOMIC_RELAXED, __HIP_MEMORY_SCOPE_AGENT); }
__device__ __forceinline__ unsigned xb_xcc_id() { return (unsigned)__builtin_amdgcn_s_getreg((3 << 11) | 20) & 0xFu; }
#define XB_SPIN(cond, bar) do { unsigned _sp = 0; while (cond) { __builtin_amdgcn_s_sleep(1); \
    if ((++_sp & 255u) == 0u) { if (xb_ld(&(bar)[XB_TMO])) break; if (_sp > XB_SPIN_CAP) { atomicAdd(&(bar)[XB_TMO], 1u); break; } } } } while (0)
struct XcdBarrier { unsigned* bar; unsigned x; volatile LAS unsigned* st; };
__device__ __forceinline__ XcdBarrier xcd_barrier_post(unsigned* bar, volatile LAS unsigned* st) {
    XcdBarrier b; b.bar = bar; b.x = xb_xcc_id(); b.st = st;
    if (threadIdx.x == 0) (void)xb_add(&bar[XB_XCNT(b.x)], 1u);
    return b;
}
__device__ __forceinline__ void xcd_barrier_complete(unsigned* bar, unsigned x, unsigned& nloc, unsigned& nx) {
    const unsigned G = gridDim.x * gridDim.y * gridDim.z;
    unsigned sum, cnt, mine, sp = 0u;
    for (;;) {
        sum = 0u; cnt = 0u; mine = 0u;
#pragma unroll
        for (unsigned j = 0; j < 16; ++j) { const unsigned c = xb_ld(&bar[XB_XCNT(j)]); sum += c; cnt += (c > 0u) ? 1u : 0u; mine = (j == x) ? c : mine; }
        if (sum == G) break;
        __builtin_amdgcn_s_sleep(1);
        if ((++sp & 255u) == 0u) { if (xb_ld(&bar[XB_TMO])) break; if (sp > XB_SPIN_CAP) { atomicAdd(&bar[XB_TMO], 1u); break; } }
    }
    nloc = mine > 0u ? mine : 1u; nx = cnt > 0u ? cnt : 1u;
}
__device__ __forceinline__ void xcd_barrier(const XcdBarrier& b) {
    asm volatile("s_waitcnt vmcnt(0)" ::: "memory");
    __syncthreads();
    if (threadIdx.x == 0) {
        unsigned* bar = b.bar;
        __builtin_amdgcn_s_waitcnt(0);
        unsigned nloc = b.st[0], nx = b.st[1];
        if (nloc == 0u) { xcd_barrier_complete(bar, b.x, nloc, nx); b.st[0] = nloc; b.st[1] = nx; }
        const unsigned old = xb_add(&bar[XB_XSUB(b.x)], 1u);
        const unsigned gen = old / nloc;
        if (old + 1u == (gen + 1u) * nloc) {
            __builtin_amdgcn_fence(__ATOMIC_RELEASE, "agent");
            asm volatile("s_waitcnt vmcnt(0)" ::: "memory");
            const unsigned og = xb_add(&bar[XB_TOP], 1u);
            const unsigned tg = og / nx;
            if (og + 1u == (tg + 1u) * nx) xb_add(&bar[XB_TOPGEN], 1u);
            else XB_SPIN(xb_ld(&bar[XB_TOPGEN]) == tg, bar);
            __builtin_amdgcn_fence(__ATOMIC_ACQUIRE, "agent");
            xb_add(&bar[XB_XGEN(b.x)], 1u);
            asm volatile("s_waitcnt vmcnt(0)" ::: "memory");
        } else {
            XB_SPIN(xb_ld(&bar[XB_XGEN(b.x)]) == gen, bar);
            __builtin_amdgcn_fence(__ATOMIC_ACQUIRE, "agent");
            asm volatile("s_waitcnt vmcnt(0)" ::: "memory");
        }
    }
    __syncthreads();
}

struct Frame {
    LAS unsigned char* lds;
    int tid, wave, vcu, G;
    float* out; unsigned char* ws;
};
__device__ __forceinline__ unsigned f2bf(float f) { unsigned u = __builtin_bit_cast(unsigned, f); return (u + 0x7fffu + ((u >> 16) & 1u)) >> 16; }
__device__ __forceinline__ unsigned pk2(float lo, float hi) { return f2bf(lo) | (f2bf(hi) << 16); }
__device__ __forceinline__ float wave_sum(float v) {
#pragma unroll
    for (int o = 1; o < 64; o <<= 1) v += __shfl_xor(v, o);
    return v;
}
#define LDS_WAIT() asm volatile("s_waitcnt lgkmcnt(0)" ::: "memory")

__device__ __forceinline__ int win_map(int n) { return n < 5120 ? n : (n < 5168 ? 7168 + (n - 5120) : 5120 + (n - 5168)); }
struct P0Desc { const float* W; const float* gain; bf16_t* WT; int K, N, ldt, mode, bj, k0, n0; };
__device__ __forceinline__ void p0_load(f32x4 (&v)[16], float& gv, const P0Desc& d, int lane) {
    const int n = d.n0 + 4 * (lane & 15); const bool ok = n < d.N;
    gv = d.gain ? d.gain[d.k0 + lane] : 1.0f;
    const float* __restrict__ src = d.W + (size_t)(d.k0 + 2 * (lane >> 4)) * d.N + (ok ? n : 0);
#pragma unroll
    for (int i = 0; i < 16; ++i) v[i] = __builtin_nontemporal_load((const f32x4*)(src + (size_t)(8 * (i >> 1) + (i & 1)) * d.N));
}
__device__ __forceinline__ void p0_finish(f32x4 (&v)[16], float gv, const P0Desc& d, LAS unsigned* T, int lane) {
    const int kr = lane >> 4, nq = lane & 15;
#pragma unroll
    for (int j = 0; j < 8; ++j) {
        f32x4 a = v[2 * j], b = v[2 * j + 1];
        if (d.gain) { const float g0 = __shfl(gv, 8 * j + 2 * kr), g1 = __shfl(gv, 8 * j + 2 * kr + 1); a = a * g0; b = b * g1; }
#pragma unroll
        for (int e = 0; e < 4; ++e) T[(4 * nq + e) * 33 + 4 * j + kr] = cvt_pk_bf16(a[e], b[e]);
    }
    LDS_WAIT(); asm volatile("" ::: "memory");
    const int nl = lane >> 3, c = lane & 7;
#pragma unroll
    for (int g = 0; g < 8; ++g) {
        const int nloc = 8 * g + nl, n = d.n0 + nloc;
        const LAS unsigned* t = T + nloc * 33 + 4 * c;
        u32x4 o; o.x = t[0]; o.y = t[1]; o.z = t[2]; o.w = t[3];
        const int dr = d.mode == 0 ? n : (d.mode == 1 ? win_map(n) : 256 * (n >> 7) + 128 * d.bj + (n & 127));
        if (n < d.N) *(u32x4*)(d.WT + (d.ldt ? (size_t)dr * d.ldt + d.k0 + 8 * c : blk_off(dr, d.k0 + 8 * c, d.K >> 6))) = o;
    }
    LDS_WAIT(); asm volatile("" ::: "memory");
}
constexpr int P0_I_GU = 64 * 172, P0_I_D = 172 * 64, P0_I_IN = 64 * 113, P0_I_OUT = 64 * 64, P0_I_POOL = 8 * 8, P0_I_C1 = 64 * 2, P0_I_C2 = 2 * 2;
constexpr int P0_NITEMS = 4 * P0_I_GU + 2 * P0_I_D + P0_I_IN + P0_I_OUT + 4 * P0_I_POOL + 2 * P0_I_C1 + 2 * P0_I_C2;
__device__ __forceinline__ void p0_decode(Frame& F, int it, P0Desc& d) {
    unsigned char* ws = F.ws; int r = it; d.gain = nullptr; d.mode = 0; d.bj = 0;
    if (r < 4 * P0_I_GU) { const int q = r / P0_I_GU; r -= q * P0_I_GU; d.k0 = 64 * (r / 172); d.n0 = 64 * (r % 172); d.K = DM; d.ldt = 0; d.N = FF; d.mode = 2; d.bj = q & 1;
        d.W = q == 0 ? INP(2) : q == 1 ? INP(3) : q == 2 ? INP(18) : INP(19); d.gain = q < 2 ? INP(1) : INP(17); d.WT = (bf16_t*)(ws + (q < 2 ? WS_WGU1 : WS_WGU2)); return; }
    r -= 4 * P0_I_GU;
    if (r < 2 * P0_I_D) { const int q = r / P0_I_D; r -= q * P0_I_D; d.k0 = 64 * (r / 64); d.n0 = 64 * (r % 64); d.K = FF; d.ldt = 0; d.N = DM; d.W = q == 0 ? INP(4) : INP(20); d.WT = (bf16_t*)(ws + (q == 0 ? WS_WD1 : WS_WD2)); return; }
    r -= 2 * P0_I_D;
    if (r < P0_I_IN) { d.k0 = 64 * (r / 113); d.n0 = 64 * (r % 113); d.K = DM; d.ldt = 0; d.N = NIN; d.mode = 1; d.W = INP(6); d.gain = INP(5); d.WT = (bf16_t*)(ws + WS_WIN); return; }
    r -= P0_I_IN;
    if (r < P0_I_OUT) { d.k0 = 64 * (r / 64); d.n0 = 64 * (r % 64); d.K = DM; d.ldt = 0; d.N = DM; d.W = INP(15); d.WT = (bf16_t*)(ws + WS_WOUT); return; }
    r -= P0_I_OUT;
    if (r < 4 * P0_I_POOL) { const int q = r / P0_I_POOL; r -= q * P0_I_POOL; d.k0 = 64 * (r / 8); d.n0 = 64 * (r % 8); d.K = 512; d.ldt = 0; d.N = 512; d.W = INP(13) + (size_t)q * 512 * 512; d.WT = (bf16_t*)(ws + WS_SMALL + SM_WPOOL) + (size_t)q * 512 * 512; return; }
    r -= 4 * P0_I_POOL;
    if (r < 2 * P0_I_C1) { const int q = r / P0_I_C1; r -= q * P0_I_C1; d.k0 = 64 * (r / 2); d.n0 = 64 * (r % 2); d.K = 4096; d.ldt = 4096; d.N = 128; d.W = q == 0 ? INP(8) : INP(11); d.WT = (bf16_t*)(ws + WS_SMALL + (q == 0 ? SM_WCK1 : SM_WCV1)); return; }
    r -= 2 * P0_I_C1;
    { const int q = r / P0_I_C2; r -= q * P0_I_C2; d.k0 = 64 * (r / 2); d.n0 = 64 * (r % 2); d.K = 128; d.ldt = 128; d.N = 128; d.W = q == 0 ? INP(9) : INP(12); d.WT = (bf16_t*)(ws + WS_SMALL + (q == 0 ? SM_WCK2 : SM_WCV2)); }
}

__device__ __forceinline__ void p0_convert(Frame& F, int lo, int hi, int worker, int nworkers) {
    const int lane = (F.tid & 63), stride = nworkers * 8, first = lo + worker * 8 + F.wave;
    LAS unsigned* T = (LAS unsigned*)(F.lds + F.wave * 16384);
    if (first >= hi) return;
    const int n_my = (hi - first + stride - 1) / stride;
    f32x4 va[16], vb[16]; float ga, gb; P0Desc da, db;
    p0_decode(F, first, da); p0_load(va, ga, da, lane);
    for (int i = 0; i < n_my; i += 2) {
        { const int j = i + 1 < n_my ? i + 1 : n_my - 1; p0_decode(F, first + j * stride, db); p0_load(vb, gb, db, lane); }
        p0_finish(va, ga, da, T, lane);
        { const int j = i + 2 < n_my ? i + 2 : n_my - 1; p0_decode(F, first + j * stride, da); p0_load(va, ga, da, lane); }
        if (i + 1 < n_my) p0_finish(vb, gb, db, T, lane);
    }
}
constexpr int P0_R_GU2 = 2 * P0_I_GU, P0_R_D1 = 4 * P0_I_GU, P0_R_D2 = P0_R_D1 + P0_I_D, P0_R_IN = P0_R_D2 + P0_I_D, P0_R_OUT = P0_R_IN + P0_I_IN, P0_R_SMALL = P0_R_OUT + P0_I_OUT;
__device__ __forceinline__ void p0_convert_simple(Frame& F, int lo, int hi, int worker, int nworkers) {
    const int lane = (F.tid & 63), stride = nworkers * 8;
    LAS unsigned* T = (LAS unsigned*)(F.lds + F.wave * 16384);
    for (int it = lo + worker * 8 + F.wave; it < hi; it += stride) { f32x4 va[16]; float ga; P0Desc da; p0_decode(F, it, da); p0_load(va, ga, da, lane); p0_finish(va, ga, da, T, lane); }
}
__device__ __forceinline__ void tail_convert(Frame& F, int nwg, int lo, int hi) {
    const int r = nwg % F.G, c = (int)blockIdx.x;
    if (r == 0) p0_convert(F, lo, hi, c, F.G);
    else if (c >= r) p0_convert_simple(F, lo, hi, c - r, F.G - r);
}

__device__ __forceinline__ int gu_dest(int n, int bj) { return 256 * (n >> 7) + 128 * bj + (n & 127); }
__device__ __forceinline__ int q8(float x) { x = __builtin_rintf(x); x = x > 127.f ? 127.f : (x < -127.f ? -127.f : x); return (int)x; }
__device__ __forceinline__ unsigned pack4_i8(float a, float b, float c, float d) {
    unsigned w = __builtin_amdgcn_cvt_pk_u8_f32(a + 128.0f, 0u, 0u); w = __builtin_amdgcn_cvt_pk_u8_f32(b + 128.0f, 1u, w); w = __builtin_amdgcn_cvt_pk_u8_f32(c + 128.0f, 2u, w); w = __builtin_amdgcn_cvt_pk_u8_f32(d + 128.0f, 3u, w);
    return w ^ 0x80808080u;
}
constexpr int GU_STRIPS = 5504, GU_STRIPS_ALL = 5504 + 22 * 64;
template <int ROT>
__device__ __forceinline__ void gu_absmax(Frame& F, int s_lo, int s_hi) {
    const int gw = F.vcu * 8 + F.wave, NGW = F.G * 8, lane = (F.tid & 63), kr = lane >> 4, nq = lane & 15;
    for (int sidx = s_lo + gw; sidx < s_hi; sidx += NGW) {
        int q, r; if (sidx < GU_STRIPS) { q = sidx / 1376; r = sidx % 1376; } else if (sidx < GU_STRIPS_ALL) { q = 4; r = sidx - GU_STRIPS; } else { q = 5; r = sidx - GU_STRIPS_ALL; }
        const int nbk = q < 4 ? 172 : 64, kb = r / nbk, nb = r % nbk, rowlen = q < 4 ? FF : DM, ktot = q < 4 ? DM : FF;
        const float* W = q == 0 ? INP(2) : q == 1 ? INP(3) : q == 2 ? INP(18) : q == 3 ? INP(19) : q == 4 ? INP(20) : INP(4); const float* gain = q < 2 ? INP(1) : (q < 4 ? INP(17) : nullptr);
        unsigned* cmax = (unsigned*)(F.ws + WS_CTL + CTL_CMAX) + (q < 4 ? (q >> 1) * NGU : 2 * NGU + (q - 4) * DM);
        const int n = 64 * nb + 4 * nq;
        const float* src = W + (size_t)(512 * kb + 2 * kr) * rowlen + n;
        int ntl = (ktot - 512 * kb) / 64; ntl = ntl > 8 ? 8 : ntl;
        f32x4 cm = (f32x4){0.f, 0.f, 0.f, 0.f};
#pragma unroll 2
        for (int t = 0; t < ntl; ++t) {
            const float gv = gain ? gain[512 * kb + 64 * t + lane] : 1.0f;
            f32x4 v[16];
#pragma unroll
            for (int i = 0; i < 16; ++i) v[i] = *(const f32x4*)(src + (size_t)(64 * t + 8 * (i >> 1) + (i & 1)) * rowlen);
            if (ROT) {
#pragma unroll
                for (int st = 1; st <= (ROT <= 3 ? 1 : ROT == 4 ? 2 : 4); st <<= 1)
#pragma unroll
                    for (int i = 0; i < 16; ++i) if (!(i & st)) { const f32x4 a = v[i], b = v[i | st]; v[i] = a + b; v[i | st] = a - b; }
                { const bool s16 = (lane & 16) != 0, s32 = (lane & 32) != 0;
#pragma unroll
                  for (int i = 0; i < 16; ++i)
#pragma unroll
                      for (int e = 0; e < 4; ++e) { float x = v[i][e]; if (ROT >= 2) x = bfly16(x, s16); if (ROT >= 3) x = bfly32(x, s32); v[i][e] = x; } }
#pragma unroll
                for (int i = 0; i < 16; ++i) v[i] *= (ROT == 1 ? 0.70710678118654752f : ROT == 2 ? 0.5f : ROT == 3 ? 0.35355339059327373f : ROT == 4 ? 0.25f : 0.17677669529663687f);
            }
#pragma unroll
            for (int i = 0; i < 16; ++i) { const float g = __shfl(gv, 8 * (i >> 1) + 2 * kr + (i & 1)); const f32x4 a = __builtin_elementwise_abs(v[i] * g); cm = __builtin_elementwise_max(cm, a); }
        }
#pragma unroll
        for (int e = 0; e < 4; ++e) { float c = cm[e]; c = fmaxf(c, __shfl_xor(c, 16)); c = fmaxf(c, __shfl_xor(c, 32)); cm[e] = c; }
        if (kr == 0) {
            const int d0 = q < 4 ? gu_dest(n, q & 1) : n;
#pragma unroll
            for (int e = 0; e < 4; ++e) atomicMax(cmax + d0 + e, __float_as_uint(cm[e]));
        }
    }
}
struct GUDesc { const float* W; const float* gain; unsigned char* WQ; const unsigned* cmax; float* sb; int bj, k0, n0, N, kt8, il; };
constexpr int Q_R_D1Q = 5 * P0_I_GU;
constexpr int Q_R_D2 = 4 * P0_I_GU;
__device__ __forceinline__ void gu_decode(Frame& F, int it, GUDesc& d) {
    const int q = it / P0_I_GU, r = it % P0_I_GU;
    if (q < 4) { d.k0 = 128 * (r / 344); d.n0 = 32 * (r % 344); d.bj = q & 1; d.N = FF; d.kt8 = KT8; d.il = 1;
        d.W = q == 0 ? INP(2) : q == 1 ? INP(3) : q == 2 ? INP(18) : INP(19); d.gain = q < 2 ? INP(1) : INP(17);
        d.WQ = F.ws + (q < 2 ? WS_WGU1 : WS_WGU2); d.cmax = (const unsigned*)(F.ws + WS_CTL + CTL_CMAX) + (q >> 1) * NGU; d.sb = (float*)(F.ws + WS_SMALL + (q < 2 ? SM_SB1 : SM_SB2)); }
    else { d.k0 = 128 * (r / 128); d.n0 = 32 * (r % 128); d.bj = 0; d.N = DM; d.kt8 = FF / 128; d.il = 0; d.W = q == 4 ? INP(20) : INP(4); d.gain = nullptr;
        d.WQ = F.ws + (q == 4 ? WS_WD2 : WS_WD1); d.cmax = (const unsigned*)(F.ws + WS_CTL + CTL_CMAX) + 2 * NGU + (q == 4 ? 0 : DM); d.sb = (float*)(F.ws + WS_SMALL + (q == 4 ? SM_SB3 : SM_SB4)); }
}
__device__ __forceinline__ void gu_load(f32x4 (&v)[16], float& gA, float& gB, const GUDesc& d, int lane) {
    const int kr = lane >> 3, nq = lane & 7;
    const float* __restrict__ src = d.W + (size_t)(d.k0 + 4 * kr) * d.N + d.n0 + 4 * nq;
    gA = d.gain ? d.gain[d.k0 + lane] : 1.0f; gB = d.gain ? d.gain[d.k0 + 64 + lane] : 1.0f;
#pragma unroll
    for (int i = 0; i < 16; ++i) v[i] = *(const f32x4*)(src + (size_t)(32 * (i >> 2) + (i & 3)) * d.N);
}
template <int ROT>
__device__ __forceinline__ void rot32_tile(f32x4 (&v)[16], int lane) {
#pragma unroll
    for (int jq = 0; jq < 4; ++jq) {
        const f32x4 a = v[4 * jq], b = v[4 * jq + 1], c = v[4 * jq + 2], d = v[4 * jq + 3];
        const f32x4 a1 = a + b, b1 = a - b, c1 = c + d, d1 = c - d;
        if (ROT >= 2) { v[4 * jq] = a1 + c1; v[4 * jq + 2] = a1 - c1; v[4 * jq + 1] = b1 + d1; v[4 * jq + 3] = b1 - d1; }
        else { v[4 * jq] = a1; v[4 * jq + 1] = b1; v[4 * jq + 2] = c1; v[4 * jq + 3] = d1; }
    }
    { const bool s8 = (lane & 8) != 0, s16 = (lane & 16) != 0, s32 = (lane & 32) != 0;
#pragma unroll
      for (int i = 0; i < 16; ++i)
#pragma unroll
          for (int e = 0; e < 4; ++e) { float x = v[i][e]; if (ROT >= 3) x = bfly8(x, s8); if (ROT >= 4) x = bfly16(x, s16); if (ROT >= 5) x = bfly32(x, s32); v[i][e] = x; } }
#pragma unroll
    for (int i = 0; i < 16; ++i) v[i] *= (ROT == 1 ? 0.70710678118654752f : ROT == 2 ? 0.5f : ROT == 3 ? 0.35355339059327373f : ROT == 4 ? 0.25f : 0.17677669529663687f);
}
template <bool STRIP, int ROT>
__device__ __forceinline__ void gu_finish_t(f32x4 (&v)[16], float gA, float gB, const GUDesc& d, LAS unsigned* T, int lane, const float (&sinv)[4]) {
    const int kr = lane >> 3, nq = lane & 7;
    const int dq0 = d.il ? gu_dest(d.n0 + 4 * nq, d.bj) : d.n0 + 4 * nq;
    if (ROT) rot32_tile<ROT>(v, lane);
    float inv[4];
#pragma unroll
    for (int e = 0; e < 4; ++e) { if (STRIP) inv[e] = sinv[e]; else { const float cm = __uint_as_float(d.cmax[dq0 + e]); inv[e] = cm > 0.f ? 127.0f / cm : 0.f; } }
#pragma unroll
    for (int jq = 0; jq < 4; ++jq) {
        float g[4];
#pragma unroll
        for (int e2 = 0; e2 < 4; ++e2) g[e2] = jq < 2 ? __shfl(gA, 32 * jq + 4 * kr + e2) : __shfl(gB, 32 * (jq - 2) + 4 * kr + e2);
#pragma unroll
        for (int e = 0; e < 4; ++e)
            T[(4 * nq + e) * 33 + 8 * jq + kr] = pack4_i8(v[4 * jq + 0][e] * g[0] * inv[e], v[4 * jq + 1][e] * g[1] * inv[e], v[4 * jq + 2][e] * g[2] * inv[e], v[4 * jq + 3][e] * g[3] * inv[e]);
    }
    LDS_WAIT(); asm volatile("" ::: "memory");
    const int nl = lane >> 3, c = lane & 7;
#pragma unroll
    for (int g4 = 0; g4 < 4; ++g4) {
        const int nloc = 8 * g4 + nl, dr = d.il ? gu_dest(d.n0 + nloc, d.bj) : d.n0 + nloc;
        const LAS unsigned* t = T + nloc * 33 + 4 * c;
        u32x4 o; o.x = t[0]; o.y = t[1]; o.z = t[2]; o.w = t[3];
        *(u32x4*)(d.WQ + blk8_off(dr, d.k0 + 16 * c, d.kt8)) = o;
        if (!STRIP) if (d.k0 == 0 && c == 0) d.sb[dr] = __uint_as_float(d.cmax[dr]) * (1.0f / 127.0f);
    }
    LDS_WAIT(); asm volatile("" ::: "memory");
}
template <int ROT>
__device__ __forceinline__ void gu_finish(f32x4 (&v)[16], float gA, float gB, const GUDesc& d, LAS unsigned* T, int lane) {
    const float z[4] = {0.f, 0.f, 0.f, 0.f}; gu_finish_t<false, ROT>(v, gA, gB, d, T, lane, z);
}
constexpr int GU_UNITS_GU = 4 * 344, GU_UNITS_ALL = GU_UNITS_GU + 128;
__device__ __forceinline__ void gu_strip(Frame& F, int uidx, int par) {
    const int lane = (F.tid & 63), kr = lane >> 3, nq = lane & 7;
    const int q = uidx < GU_UNITS_GU ? uidx / 344 : 4, nb = uidx < GU_UNITS_GU ? uidx % 344 : uidx - GU_UNITS_GU;
    const int nkt = q < 4 ? 32 : 86, it0 = q * P0_I_GU + nb, its = q < 4 ? 344 : 128;
    LAS unsigned* T = (LAS unsigned*)(F.lds + F.wave * 16384);
    LAS float* part = (LAS float*)(F.lds + 131072 + 1024 * (par & 1));
    GUDesc d; gu_decode(F, it0, d);
    f32x4 cm = {0.f, 0.f, 0.f, 0.f};
    for (int kt = F.wave; kt < nkt; kt += 8) {
        f32x4 v[16]; float gA, gB; d.k0 = 128 * kt; gu_load(v, gA, gB, d, lane);
#pragma unroll
        for (int jq = 0; jq < 4; ++jq) {
#pragma unroll
            for (int e2 = 0; e2 < 4; ++e2) {
                const float g = jq < 2 ? __shfl(gA, 32 * jq + 4 * kr + e2) : __shfl(gB, 32 * (jq - 2) + 4 * kr + e2);
#pragma unroll
                for (int e = 0; e < 4; ++e) cm[e] = fmaxf(cm[e], fabsf(v[4 * jq + e2][e] * g));
            }
        }
    }
#pragma unroll
    for (int e = 0; e < 4; ++e) { float m = cm[e]; m = fmaxf(m, __shfl_xor(m, 8)); m = fmaxf(m, __shfl_xor(m, 16)); m = fmaxf(m, __shfl_xor(m, 32)); cm[e] = m; }
    if (kr == 0) { for (int e = 0; e < 4; ++e) part[F.wave * 32 + 4 * nq + e] = cm[e]; }
    __syncthreads();
    float inv[4];
#pragma unroll
    for (int e = 0; e < 4; ++e) {
        float m = 0.f;
#pragma unroll
        for (int w = 0; w < 8; ++w) m = fmaxf(m, part[w * 32 + 4 * nq + e]);
        inv[e] = m > 0.f ? 127.0f / m : 0.f;
        if (F.wave == 0 && kr == 0) { const int n = d.n0 + 4 * nq + e; d.sb[d.il ? gu_dest(n, d.bj) : n] = m * (1.0f / 127.0f); }
    }
    for (int kt = F.wave; kt < nkt; kt += 8) {
        f32x4 v[16]; float gA, gB; d.k0 = 128 * kt; gu_load(v, gA, gB, d, lane);
        gu_finish_t<true, 0>(v, gA, gB, d, T, lane, inv);
    }
    (void)its;
}
__device__ __forceinline__ void gu_strips(Frame& F, int lo, int hi, int worker, int nworkers) {
    int par = 0;
    for (int u = lo + worker; u < hi; u += nworkers, ++par) gu_strip(F, u, par);
}
__device__ __forceinline__ void tail_strips(Frame& F, int nwg, int lo, int hi) {
    const int r = nwg % F.G, c = (int)blockIdx.x;
    if (r == 0) gu_strips(F, lo, hi, c, F.G);
    else if (c >= r) gu_strips(F, lo, hi, c - r, F.G - r);
}
template <int ROT = 0>
__device__ __forceinline__ void gu_quant(Frame& F, int lo, int hi, int worker, int nworkers) {
    const int lane = (F.tid & 63), stride = nworkers * 8, first = lo + worker * 8 + F.wave;
    LAS unsigned* T = (LAS unsigned*)(F.lds + F.wave * 16384);
    if (first >= hi) return;
    const int n_my = (hi - first + stride - 1) / stride;
    f32x4 va[16], vb[16]; float gaA, gaB, gbA, gbB; GUDesc da, db;
    gu_decode(F, first, da); gu_load(va, gaA, gaB, da, lane);
    for (int i = 0; i < n_my; i += 2) {
        { const int j = i + 1 < n_my ? i + 1 : n_my - 1; gu_decode(F, first + j * stride, db); gu_load(vb, gbA, gbB, db, lane); }
        gu_finish<ROT>(va, gaA, gaB, da, T, lane);
        { const int j = i + 2 < n_my ? i + 2 : n_my - 1; gu_decode(F, first + j * stride, da); gu_load(va, gaA, gaB, da, lane); }
        if (i + 1 < n_my) gu_finish<ROT>(vb, gbA, gbB, db, T, lane);
    }
}
template <int ROT = 0>
__device__ __forceinline__ void gu_quant_simple(Frame& F, int lo, int hi, int worker, int nworkers) {
    const int lane = (F.tid & 63), stride = nworkers * 8;
    LAS unsigned* T = (LAS unsigned*)(F.lds + F.wave * 16384);
    for (int it = lo + worker * 8 + F.wave; it < hi; it += stride) { f32x4 va[16]; float gA, gB; GUDesc da; gu_decode(F, it, da); gu_load(va, gA, gB, da, lane); gu_finish<ROT>(va, gA, gB, da, T, lane); }
}
template <int ROT = 0>
__device__ __forceinline__ void tail_quant(Frame& F, int nwg, int lo, int hi) {
    const int r = nwg % F.G, c = (int)blockIdx.x;
    if (r == 0) gu_quant<ROT>(F, lo, hi, c, F.G);
    else if (c >= r) gu_quant_simple<ROT>(F, lo, hi, c - r, F.G - r);
}
__device__ __forceinline__ void quant_rows(Frame& F, const float* x, unsigned char* xq, float* ra) {
    const int gw = F.vcu * 8 + F.wave, NGW = F.G * 8, lane = (F.tid & 63);
    for (int m = gw; m < M; m += NGW) {
        const f32x4* xr = (const f32x4*)(x + (size_t)m * DM) + lane;
        f32x4 v[16]; float s = 0.f, am = 0.f;
#pragma unroll
        for (int j = 0; j < 16; ++j) { v[j] = xr[64 * j]; s += (v[j].x * v[j].x + v[j].y * v[j].y) + (v[j].z * v[j].z + v[j].w * v[j].w);
            am = fmaxf(fmaxf(am, fmaxf(__builtin_fabsf(v[j].x), __builtin_fabsf(v[j].y))), fmaxf(__builtin_fabsf(v[j].z), __builtin_fabsf(v[j].w))); }
        s = wave_sum(s);
#pragma unroll
        for (int o = 1; o < 64; o <<= 1) am = fmaxf(am, __shfl_xor(am, o));
        const float inv = am > 0.f ? 127.0f / am : 0.f;
#pragma unroll
        for (int j = 0; j < 16; ++j) *(unsigned*)(xq + blk8_off(m, 4 * lane + 256 * j, KT8)) = pack4_i8(v[j].x * inv, v[j].y * inv, v[j].z * inv, v[j].w * inv);
        if (lane == 0) ra[m] = __builtin_amdgcn_rsqf(s * (1.0f / DM) + EPS) * am * (1.0f / 127.0f);
    }
}

__device__ __forceinline__ float bflyq1(float x, bool up) { const float p = __uint_as_float(__builtin_amdgcn_update_dpp(0u, __float_as_uint(x), 0xB1, 0xf, 0xf, false)); return up ? p - x : x + p; }
__device__ __forceinline__ float bflyq2(float x, bool up) { const float p = __uint_as_float(__builtin_amdgcn_update_dpp(0u, __float_as_uint(x), 0x4E, 0xf, 0xf, false)); return up ? p - x : x + p; }
__device__ __forceinline__ void qh_load(u32x4 (&v)[22], const bf16_t* hidp, int unit, int rl, int c, int kt0, int nk) {
    const bf16_t* src = hidp + blk_off(unit * 8 + rl, 64 * kt0, KTF) + 8 * c;
#pragma unroll
    for (int t = 0; t < 22; ++t) { const int tt = t < nk ? t : nk - 1; v[t] = *(const u32x4*)(src + (size_t)tt * (256 * 64)); }
}
template <int ROT>
__device__ __forceinline__ void qh_process(Frame& F, u32x4 (&v)[22], unsigned char* hq, float* sh, int unit, int par, int rl, int c, int kt0, int nk, const bf16_t* hidp, int next_unit) {
    LAS unsigned* part = (LAS unsigned*)(F.lds + 131072);
    const int wave = F.wave, row = unit * 8 + rl;
    const bool u1 = (c & 1) != 0, u2 = (c & 2) != 0;
    unsigned mb = 0u;
#pragma unroll
    for (int t = 0; t < 22; ++t) {
        float f0 = __uint_as_float(v[t].x << 16), f1 = __uint_as_float(v[t].x & 0xffff0000u), f2 = __uint_as_float(v[t].y << 16), f3 = __uint_as_float(v[t].y & 0xffff0000u);
        float f4 = __uint_as_float(v[t].z << 16), f5 = __uint_as_float(v[t].z & 0xffff0000u), f6 = __uint_as_float(v[t].w << 16), f7 = __uint_as_float(v[t].w & 0xffff0000u);
        u32x4 w = v[t];
        if (ROT) {
#define FW_BF(a, b) { const float t_ = a; a = t_ + b; b = t_ - b; }
            FW_BF(f0, f1) FW_BF(f2, f3) FW_BF(f4, f5) FW_BF(f6, f7)
            if (ROT >= 2) { FW_BF(f0, f2) FW_BF(f1, f3) FW_BF(f4, f6) FW_BF(f5, f7) }
            if (ROT >= 3) { FW_BF(f0, f4) FW_BF(f1, f5) FW_BF(f2, f6) FW_BF(f3, f7) }
#undef FW_BF
            const float sc = (ROT == 1 ? 0.70710678118654752f : ROT == 2 ? 0.5f : ROT == 3 ? 0.35355339059327373f : ROT == 4 ? 0.25f : 0.17677669529663687f);
#define FW_Q(f) { if (ROT >= 4) f = bflyq1(f, u1); if (ROT >= 5) f = bflyq2(f, u2); f *= sc; }
            FW_Q(f0) FW_Q(f1) FW_Q(f2) FW_Q(f3) FW_Q(f4) FW_Q(f5) FW_Q(f6) FW_Q(f7)
#undef FW_Q
            w.x = cvt_pk_bf16(f0, f1); w.y = cvt_pk_bf16(f2, f3); w.z = cvt_pk_bf16(f4, f5); w.w = cvt_pk_bf16(f6, f7);
            v[t] = w;
        }
#pragma unroll
        for (int e = 0; e < 4; ++e) { const unsigned x = w[e]; const unsigned lo = (x << 16) & 0x7fff0000u, hi2 = x & 0x7fff0000u; mb = mb > lo ? mb : lo; mb = mb > hi2 ? mb : hi2; }
    }
    { unsigned o1 = __shfl_xor(mb, 1); mb = mb > o1 ? mb : o1; o1 = __shfl_xor(mb, 2); mb = mb > o1 ? mb : o1; o1 = __shfl_xor(mb, 4); mb = mb > o1 ? mb : o1; }
    if (c == 0) part[(par * 8 + wave) * 8 + rl] = mb;
    __syncthreads();
    mb = 0u;
#pragma unroll
    for (int w8 = 0; w8 < 8; ++w8) { const unsigned o1 = part[(par * 8 + w8) * 8 + rl]; mb = mb > o1 ? mb : o1; }
    const float am = __uint_as_float(mb), inv = am > 0.f ? 127.0f / am : 0.f;
    if (wave == 0 && c == 0) sh[row] = am * (1.0f / 127.0f);
#pragma unroll
    for (int t = 0; t < 22; ++t) if (t < nk) {
        typedef unsigned u32x2_t __attribute__((ext_vector_type(2)));
        u32x2_t o;
        o.x = pack4_i8(__uint_as_float(v[t].x << 16) * inv, __uint_as_float(v[t].x & 0xffff0000u) * inv, __uint_as_float(v[t].y << 16) * inv, __uint_as_float(v[t].y & 0xffff0000u) * inv);
        o.y = pack4_i8(__uint_as_float(v[t].z << 16) * inv, __uint_as_float(v[t].z & 0xffff0000u) * inv, __uint_as_float(v[t].w << 16) * inv, __uint_as_float(v[t].w & 0xffff0000u) * inv);
        *(u32x2_t*)(hq + blk8_off(row, 64 * (kt0 + t) + 8 * c, FF / 128)) = o;
    }
    if (next_unit >= 0) qh_load(v, hidp, next_unit, rl, c, kt0, nk);
}
template <int ROT>
__device__ __forceinline__ void quant_hid_rot(Frame& F, const bf16_t* hidp, unsigned char* hq, float* sh) {
    const int lane = (F.tid & 63), kq = lane >> 3, c = lane & 7;
    const int gw = F.vcu * 8 + F.wave, NGW = F.G * 8;
    const bool u1 = (c & 1) != 0, u2 = (c & 2) != 0, lastok = kq < 4;
    for (int row = gw; row < M; row += NGW) {
        const bf16_t* src = hidp + blk_off(row, 64 * kq, KTF) + 8 * c;
        u32x4 v[22];
#pragma unroll
        for (int j = 0; j < 22; ++j) v[j] = *(const u32x4*)(src + (size_t)((j < 21 || lastok) ? 8 * j : 0) * (256 * 64));
        float am = 0.f;
#pragma unroll
        for (int j = 0; j < 22; ++j) {
            float f0 = __uint_as_float(v[j].x << 16), f1 = __uint_as_float(v[j].x & 0xffff0000u), f2 = __uint_as_float(v[j].y << 16), f3 = __uint_as_float(v[j].y & 0xffff0000u);
            float f4 = __uint_as_float(v[j].z << 16), f5 = __uint_as_float(v[j].z & 0xffff0000u), f6 = __uint_as_float(v[j].w << 16), f7 = __uint_as_float(v[j].w & 0xffff0000u);
            if (ROT) {
#define FW_BF(a, b) { const float t_ = a; a = t_ + b; b = t_ - b; }
                FW_BF(f0, f1) FW_BF(f2, f3) FW_BF(f4, f5) FW_BF(f6, f7)
                if (ROT >= 2) { FW_BF(f0, f2) FW_BF(f1, f3) FW_BF(f4, f6) FW_BF(f5, f7) }
                if (ROT >= 3) { FW_BF(f0, f4) FW_BF(f1, f5) FW_BF(f2, f6) FW_BF(f3, f7) }
#undef FW_BF
                const float sc = (ROT == 1 ? 0.70710678118654752f : ROT == 2 ? 0.5f : ROT == 3 ? 0.35355339059327373f : ROT == 4 ? 0.25f : 0.17677669529663687f);
#define FW_Q(f) { if (ROT >= 4) f = bflyq1(f, u1); if (ROT >= 5) f = bflyq2(f, u2); f *= sc; }
                FW_Q(f0) FW_Q(f1) FW_Q(f2) FW_Q(f3) FW_Q(f4) FW_Q(f5) FW_Q(f6) FW_Q(f7)
#undef FW_Q
                u32x4 w; w.x = cvt_pk_bf16(f0, f1); w.y = cvt_pk_bf16(f2, f3); w.z = cvt_pk_bf16(f4, f5); w.w = cvt_pk_bf16(f6, f7);
                v[j] = w;
            }
            am = fmaxf(fmaxf(am, fmaxf(__builtin_fabsf(f0), __builtin_fabsf(f1))), fmaxf(__builtin_fabsf(f2), __builtin_fabsf(f3)));
            am = fmaxf(fmaxf(am, fmaxf(__builtin_fabsf(f4), __builtin_fabsf(f5))), fmaxf(__builtin_fabsf(f6), __builtin_fabsf(f7)));
        }
#pragma unroll
        for (int o = 1; o < 64; o <<= 1) am = fmaxf(am, __shfl_xor(am, o));
        am *= 1.00390625f;
        const float inv = am > 0.f ? 127.0f / am : 0.f;
        if (lane == 0) sh[row] = am * (1.0f / 127.0f);
#pragma unroll
        for (int j = 0; j < 22; ++j) if (j < 21 || lastok) {
            typedef unsigned u32x2_t __attribute__((ext_vector_type(2)));
            u32x2_t o;
            o.x = pack4_i8(__uint_as_float(v[j].x << 16) * inv, __uint_as_float(v[j].x & 0xffff0000u) * inv, __uint_as_float(v[j].y << 16) * inv, __uint_as_float(v[j].y & 0xffff0000u) * inv);
            o.y = pack4_i8(__uint_as_float(v[j].z << 16) * inv, __uint_as_float(v[j].z & 0xffff0000u) * inv, __uint_as_float(v[j].w << 16) * inv, __uint_as_float(v[j].w & 0xffff0000u) * inv);
            *(u32x2_t*)(hq + blk8_off(row, 64 * (8 * j + kq) + 8 * c, FF / 128)) = o;
        }
    }
}
__device__ __forceinline__ void quant_hid(Frame& F) {
    const int gw = F.vcu * 8 + F.wave, NGW = F.G * 8, lane = (F.tid & 63), rloc = lane >> 3, c = lane & 7;
    const bf16_t* hidp = (const bf16_t*)(F.ws + WS_HID); unsigned char* hq = F.ws + WS_HIDQ;
    const unsigned* rmax = (const unsigned*)(F.ws + WS_CTL + CTL_RMAX); float* sh = (float*)(F.ws + WS_SMALL + SM_SH);
    for (int it = gw; it < 32 * 86 * 2; it += NGW) {
        const int half = it & 1, kt8 = (it >> 1) % 86, pm = (it >> 1) / 86;
        const bf16_t* src = hidp + ((size_t)(pm * KTF + 2 * kt8 + (c >> 2)) * 256) * 64 + 16 * (c & 3);
        unsigned char* dst = hq + ((size_t)(pm * 86 + kt8) * 256) * 128 + 16 * c;
#pragma unroll 4
        for (int i = 0; i < 16; ++i) {
            const int rl = 128 * half + 8 * i + rloc, row = 256 * pm + rl;
            const float am = __uint_as_float(rmax[row]); const float inv = am > 0.f ? 127.0f / am : 0.f;
            const u32x4 a = *(const u32x4*)(src + (size_t)rl * 64), b = *(const u32x4*)(src + (size_t)rl * 64 + 8);
            u32x4 o;
#define Q2(x, y) pack4_i8(__uint_as_float((x) << 16) * inv, __uint_as_float((x) & 0xffff0000u) * inv, __uint_as_float((y) << 16) * inv, __uint_as_float((y) & 0xffff0000u) * inv)
            o.x = Q2(a.x, a.y); o.y = Q2(a.z, a.w); o.z = Q2(b.x, b.y); o.w = Q2(b.z, b.w);
#undef Q2
            *(u32x4*)(dst + (size_t)rl * 128) = o;
            if (kt8 == 0 && c == 0) sh[row] = am * (1.0f / 127.0f);
        }
    }
}

__device__ __forceinline__ void p0_prologue(Frame& F) {
    const int gw = F.vcu * 8 + F.wave, NGW = F.G * 8, lane = (F.tid & 63);
    unsigned char* ws = F.ws;
    p0_convert(F, P0_R_IN, P0_R_OUT, F.vcu, F.G);
    gu_quant<ROT1>(F, Q_R_D1Q, Q_R_D1Q + 5408, F.vcu, F.G);
    gu_quant<ROT2>(F, Q_R_D2, Q_R_D2 + 1708, F.vcu, F.G);
    p0_convert(F, P0_R_SMALL, P0_NITEMS, F.vcu, F.G);
    quant_rows(F, INP(0), F.ws + WS_XQ, (float*)(F.ws + WS_SMALL + SM_RA0));
    for (int t = gw; t < 256; t += NGW) {
        const int kv = t >> 7, ch = t & 127; const float* pos = (kv ? INP(10) : INP(7)) + ch * 32; const float* W1 = (kv ? INP(11) : INP(8)) + (size_t)ch * 32 * 128;
        float a0 = 0.f, a1 = 0.f;
#pragma unroll 8
        for (int k = 0; k < 32; ++k) { const float p = pos[k]; a0 += p * W1[k * 128 + lane]; a1 += p * W1[k * 128 + 64 + lane]; }
        float* pb = (float*)(ws + WS_SMALL + SM_PBP) + (size_t)t * 128; pb[lane] = a0; pb[64 + lane] = a1;
    }
    gu_strips(F, 0, 688, F.vcu, F.G);
    if (gw < 6) { u32x4* p = (u32x4*)(ws + WS_KV + (size_t)gw * KV_STRIDE_B + 8 * MiB); for (int i = lane; i < 4096; i += 64) p[i] = (u32x4){0u, 0u, 0u, 0u}; }
}

__device__ __forceinline__ void compress_unit(Frame& F, int kv, int rt) {
    const int tid = F.tid, lane = (F.tid & 63), wid = F.wave, r32 = lane & 31, hi = lane >> 5;
    unsigned char* ws = F.ws;
    const bf16_t* Af = (const bf16_t*)(ws + WS_KV + (size_t)kv * KV_STRIDE_B);
    const bf16_t* W1t = (const bf16_t*)(ws + WS_SMALL + (kv ? SM_WCV1 : SM_WCK1));
    const bf16_t* W2t = (const bf16_t*)(ws + WS_SMALL + (kv ? SM_WCV2 : SM_WCK2));
    bf16_t* outp = (bf16_t*)(ws + (kv ? WS_VCMP : WS_KCMP));
    const int R0 = rt * 32;
    LAS float* red = (LAS float*)F.lds;
    __syncthreads();
    f32x16 acc[4];
#pragma unroll
    for (int nb = 0; nb < 4; ++nb) acc[nb] = f32x16{};
    const bf16_t* ap = Af + (size_t)(R0 + r32) * 2048 + wid * 512 + hi * 8;
    const bf16_t* bp = W1t + (size_t)r32 * 4096 + wid * 512 + hi * 8;
#pragma unroll 8
    for (int ks = 0; ks < 32; ++ks) {
        const bf16x8 a = *(const bf16x8*)(ap + ks * 16);
#pragma unroll
        for (int nb = 0; nb < 4; ++nb) { const bf16x8 b = *(const bf16x8*)(bp + (size_t)nb * 32 * 4096 + ks * 16); acc[nb] = __builtin_amdgcn_mfma_f32_32x32x16_bf16(a, b, acc[nb], 0, 0, 0); }
    }
#pragma unroll
    for (int nb = 0; nb < 4; ++nb)
#pragma unroll
        for (int r = 0; r < 16; ++r) red[(wid * 32 + ((r & 3) + 8 * (r >> 2) + 4 * hi)) * 128 + nb * 32 + r32] = acc[nb][r];
    __syncthreads();
    float hv[8];
    {
        const int n = tid & 127;
        const float pbias = ((const float*)(ws + WS_CTL + CTL_PBSUM))[kv * 128 + n];
#pragma unroll
        for (int e = 0; e < 8; ++e) { const int c = (tid >> 7) * 8 + e; float s = 0.f;
#pragma unroll
            for (int w = 0; w < 8; ++w) s += red[(w * 32 + c) * 128 + n];
            s += pbias; hv[e] = s * __builtin_amdgcn_rcpf(1.0f + __builtin_amdgcn_exp2f(-s * LOG2E)); }
    }
    __syncthreads();
    LAS bf16_t* h1 = (LAS bf16_t*)F.lds;
    { const int n = tid & 127;
#pragma unroll
        for (int e = 0; e < 8; ++e) { const int c = (tid >> 7) * 8 + e; h1[c * 136 + n] = (bf16_t)f2bf(hv[e]); } }
    __syncthreads();
    if (wid < 4) {
        f32x16 o = f32x16{};
#pragma unroll
        for (int ks = 0; ks < 8; ++ks) {
            const bf16x8 a = *(const LAS bf16x8*)(h1 + r32 * 136 + ks * 16 + hi * 8);
            const bf16x8 b = *(const bf16x8*)(W2t + (size_t)(wid * 32 + r32) * 128 + ks * 16 + hi * 8);
            o = __builtin_amdgcn_mfma_f32_32x32x16_bf16(a, b, o, 0, 0, 0);
        }
#pragma unroll
        for (int r = 0; r < 16; ++r) outp[(size_t)(R0 + (r & 3) + 8 * (r >> 2) + 4 * hi) * 128 + wid * 32 + r32] = (bf16_t)f2bf(o[r]);
    }
    __syncthreads();
}

template <int W>
__device__ __forceinline__ void pool_d_seg(const float* ub, bf16_t* db, int t0, int cq) {
    f32x4 ring[W]; f32x4 sum = (f32x4){0.f, 0.f, 0.f, 0.f};
    const int tp0 = t0 & 2047;
#pragma unroll
    for (int i = 0; i < W; ++i) { ring[i] = (tp0 - W + i >= 0) ? *(const f32x4*)(ub + (size_t)(t0 - W + i) * DPOOL + 4 * cq) : (f32x4){0.f, 0.f, 0.f, 0.f}; sum += ring[i]; }
    for (int c0 = 0; c0 < 32; c0 += W) {
#pragma unroll
        for (int i = 0; i < W; ++i) {
            const int t = t0 + c0 + i; const f32x4 x = *(const f32x4*)(ub + (size_t)t * DPOOL + 4 * cq);
            sum = sum + x - ring[i]; ring[i] = x;
            const int tp = tp0 + c0 + i; const float inv = 1.0f / (float)(tp + 1 < W ? tp + 1 : W);
            const f32x4 d = sum * inv - x;
            u32x2 w; w.x = cvt_pk_bf16(d.x, d.y); w.y = cvt_pk_bf16(d.z, d.w);
            *(u32x2*)(db + (size_t)(cq >> 7) * M * 512 + blk_off(t, (4 * cq) & 511, KTP)) = w;
        }
    }
}
__device__ __forceinline__ void pool_d_unit(Frame& F, int seg) {
    const float* ub = (const float*)(F.ws + WS_U); bf16_t* db = (bf16_t*)(F.ws + WS_DPOOL);
    const int cq = F.tid, gi = cq >> 7, t0 = seg * 32;
    if (gi == 0) pool_d_seg<2>(ub, db, t0, cq); else if (gi == 1) pool_d_seg<4>(ub, db, t0, cq); else if (gi == 2) pool_d_seg<8>(ub, db, t0, cq); else pool_d_seg<16>(ub, db, t0, cq);
}

constexpr int SHM_T = 64 * 128 * 2;
constexpr int AT_V = 0  , AT_K = 3 * SHM_T  , AT_WS = 5 * SHM_T  , AT_LUT = AT_WS + 2048  , AT_GL = AT_LUT + 4 * 304 * 4  ;
constexpr int AT_SEL = AT_GL + 3072  , AT_IMPS = AT_SEL + 256  , AT_IMPH = AT_IMPS + 64 * 33 * 4  , AT_END = AT_IMPH + 4 * 64 * 33 * 4;
static_assert(AT_END <= CTRL_OFF, "attention LDS");
#define KSWZ(row, colB) ((row) * 256 + ((colB) ^ (((row) & 7) << 4)))
#define SBAR() __builtin_amdgcn_sched_barrier(0)
__device__ __forceinline__ int v_st(int k, int c) { const int kk = (k & ~0xC) | ((k & 4) << 1) | ((k & 8) >> 1); return ((kk >> 3) * 4 + (c >> 5)) * 512 + ((kk & 7) * 32 + (c & 31)) * 2; }
__device__ __forceinline__ int v_rd_base(int lane) { return ((lane & 3) << 3) | (((lane >> 2) & 3) << 6) | (((lane >> 4) & 1) << 5) | (((lane >> 5) & 1) << 8); }
constexpr int v_rd_off(int d0, int ks, int half) { return d0 * 512 + ks * 4096 + half * 2048; }
__device__ __forceinline__ int crow(int r, int hi) { return (r & 3) + 8 * (r >> 2) + 4 * hi; }

__device__ __forceinline__ void qkt(f32x16& p0, f32x16& p1, const LAS unsigned char* Kt, int r32, int hi, const bf16x8* qr, float init) {
    f32x16 zi;
#pragma unroll
    for (int r = 0; r < 16; ++r) zi[r] = init;
    const int kt = (int)(uintptr_t)Kt;
    const int a0 = kt + KSWZ(r32, (0 * 16 + hi * 8) * 2), a1 = kt + KSWZ(r32, (1 * 16 + hi * 8) * 2), a2 = kt + KSWZ(r32, (2 * 16 + hi * 8) * 2), a3 = kt + KSWZ(r32, (3 * 16 + hi * 8) * 2);
#define DSR128(dst, addr, off) asm volatile("ds_read_b128 %0, %1 offset:%2" : "=&v"(dst) : "v"(addr), "i"(off) : "memory")
    bf16x8 f0, f1, f2, f3, g0, g1, g2, g3, f4, f5, f6, f7, g4, g5, g6, g7;
    DSR128(f0, a0, 0); DSR128(g0, a0, 8192); DSR128(f1, a1, 0); DSR128(g1, a1, 8192); DSR128(f2, a2, 0); DSR128(g2, a2, 8192); DSR128(f3, a3, 0); DSR128(g3, a3, 8192);
    asm volatile("s_waitcnt lgkmcnt(0)" : "+v"(f0), "+v"(g0), "+v"(f1), "+v"(g1), "+v"(f2), "+v"(g2), "+v"(f3), "+v"(g3) :: "memory");
    DSR128(f4, a0, 128); DSR128(g4, a0, 8320); DSR128(f5, a1, 128); DSR128(g5, a1, 8320); DSR128(f6, a2, 128); DSR128(g6, a2, 8320); DSR128(f7, a3, 128); DSR128(g7, a3, 8320);
    SBAR();
    p0 = __builtin_amdgcn_mfma_f32_32x32x16_bf16(f0, qr[0], zi, 0, 0, 0); p1 = __builtin_amdgcn_mfma_f32_32x32x16_bf16(g0, qr[0], zi, 0, 0, 0);
    p0 = __builtin_amdgcn_mfma_f32_32x32x16_bf16(f1, qr[1], p0, 0, 0, 0); p1 = __builtin_amdgcn_mfma_f32_32x32x16_bf16(g1, qr[1], p1, 0, 0, 0);
    p0 = __builtin_amdgcn_mfma_f32_32x32x16_bf16(f2, qr[2], p0, 0, 0, 0); p1 = __builtin_amdgcn_mfma_f32_32x32x16_bf16(g2, qr[2], p1, 0, 0, 0);
    p0 = __builtin_amdgcn_mfma_f32_32x32x16_bf16(f3, qr[3], p0, 0, 0, 0); p1 = __builtin_amdgcn_mfma_f32_32x32x16_bf16(g3, qr[3], p1, 0, 0, 0);
    asm volatile("s_waitcnt lgkmcnt(0)" : "+v"(f4), "+v"(g4), "+v"(f5), "+v"(g5), "+v"(f6), "+v"(g6), "+v"(f7), "+v"(g7) :: "memory");
    SBAR();
    p0 = __builtin_amdgcn_mfma_f32_32x32x16_bf16(f4, qr[4], p0, 0, 0, 0); p1 = __builtin_amdgcn_mfma_f32_32x32x16_bf16(g4, qr[4], p1, 0, 0, 0);
    p0 = __builtin_amdgcn_mfma_f32_32x32x16_bf16(f5, qr[5], p0, 0, 0, 0); p1 = __builtin_amdgcn_mfma_f32_32x32x16_bf16(g5, qr[5], p1, 0, 0, 0);
    p0 = __builtin_amdgcn_mfma_f32_32x32x16_bf16(f6, qr[6], p0, 0, 0, 0); p1 = __builtin_amdgcn_mfma_f32_32x32x16_bf16(g6, qr[6], p1, 0, 0, 0);
    p0 = __builtin_amdgcn_mfma_f32_32x32x16_bf16(f7, qr[7], p0, 0, 0, 0); p1 = __builtin_amdgcn_mfma_f32_32x32x16_bf16(g7, qr[7], p1, 0, 0, 0);
#undef DSR128
}
__device__ __forceinline__ void lut_add(f32x16& p0, f32x16& p1, const LAS float* lb) {
    const int la = (int)(uintptr_t)lb;
    float t0[16], t1[16];
#define DSR32(dst, off) asm volatile("ds_read_b32 %0, %1 offset:%2" : "=&v"(dst) : "v"(la), "i"(off) : "memory")
#define LUT_RD(r) do { constexpr int c_ = ((r) & 3) + 8 * ((r) >> 2); DSR32(t0[r], (59 - c_) * 4); DSR32(t1[r], (27 - c_) * 4); } while (0)
    LUT_RD(0); LUT_RD(1); LUT_RD(2); LUT_RD(3); LUT_RD(4); LUT_RD(5); LUT_RD(6); LUT_RD(7); LUT_RD(8); LUT_RD(9); LUT_RD(10); LUT_RD(11); LUT_RD(12); LUT_RD(13); LUT_RD(14); LUT_RD(15);
#undef LUT_RD
#undef DSR32
    asm volatile("s_waitcnt lgkmcnt(0)" : "+v"(t0[0]), "+v"(t0[1]), "+v"(t0[2]), "+v"(t0[3]), "+v"(t0[4]), "+v"(t0[5]), "+v"(t0[6]), "+v"(t0[7]), "+v"(t0[8]), "+v"(t0[9]), "+v"(t0[10]), "+v"(t0[11]), "+v"(t0[12]), "+v"(t0[13]), "+v"(t0[14]), "+v"(t0[15]) :: "memory");
    asm volatile("" : "+v"(t1[0]), "+v"(t1[1]), "+v"(t1[2]), "+v"(t1[3]), "+v"(t1[4]), "+v"(t1[5]), "+v"(t1[6]), "+v"(t1[7]), "+v"(t1[8]), "+v"(t1[9]), "+v"(t1[10]), "+v"(t1[11]), "+v"(t1[12]), "+v"(t1[13]), "+v"(t1[14]), "+v"(t1[15]) :: "memory");
    SBAR();
#pragma unroll
    for (int r = 0; r < 16; ++r) { p0[r] += t0[r]; p1[r] += t1[r]; }
}
__device__ __forceinline__ void pv_tile(f32x16* o, int vb, bf16x8 pa0, bf16x8 pa1, bf16x8 pa2, bf16x8 pa3) {
#define TRRD(dst, off) asm volatile("ds_read_b64_tr_b16 %0, %1 offset:%2" : "=&v"(dst) : "v"(vb), "i"(off) : "memory")
#define PV_D0(d0) do { s16x4 l0, l1, l2, l3, h0, h1, h2, h3; constexpr int b_ = v_rd_off(d0, 0, 0); \
        TRRD(l0, b_); TRRD(h0, b_ + 2048); TRRD(l1, b_ + 4096); TRRD(h1, b_ + 6144); TRRD(l2, b_ + 8192); TRRD(h2, b_ + 10240); TRRD(l3, b_ + 12288); TRRD(h3, b_ + 14336); \
        asm volatile("s_waitcnt lgkmcnt(0)" ::: "memory"); SBAR(); \
        o[d0] = __builtin_amdgcn_mfma_f32_32x32x16_bf16(pa0, (bf16x8){l0[0], l0[1], l0[2], l0[3], h0[0], h0[1], h0[2], h0[3]}, o[d0], 0, 0, 0); \
        o[d0] = __builtin_amdgcn_mfma_f32_32x32x16_bf16(pa1, (bf16x8){l1[0], l1[1], l1[2], l1[3], h1[0], h1[1], h1[2], h1[3]}, o[d0], 0, 0, 0); \
        o[d0] = __builtin_amdgcn_mfma_f32_32x32x16_bf16(pa2, (bf16x8){l2[0], l2[1], l2[2], l2[3], h2[0], h2[1], h2[2], h2[3]}, o[d0], 0, 0, 0); \
        o[d0] = __builtin_amdgcn_mfma_f32_32x32x16_bf16(pa3, (bf16x8){l3[0], l3[1], l3[2], l3[3], h3[0], h3[1], h3[2], h3[3]}, o[d0], 0, 0, 0); } while (0)
    PV_D0(0); PV_D0(1); PV_D0(2); PV_D0(3);
#undef PV_D0
#undef TRRD
}
__device__ __forceinline__ void pack_p(const f32x16& p0, const f32x16& p1, bf16x8& pa0, bf16x8& pa1, bf16x8& pa2, bf16x8& pa3) {
#define PK4(P, B_, OUT) do { unsigned a0 = cvt_pk_bf16(P[B_+0], P[B_+1]), a1 = cvt_pk_bf16(P[B_+2], P[B_+3]); \
        unsigned b0 = cvt_pk_bf16(P[B_+4], P[B_+5]), b1 = cvt_pk_bf16(P[B_+6], P[B_+7]); \
        auto r0 = __builtin_amdgcn_permlane32_swap(a0, b0, false, false); auto r1 = __builtin_amdgcn_permlane32_swap(a1, b1, false, false); \
        u32x4 w = {r0[0], r1[0], r0[1], r1[1]}; OUT = __builtin_bit_cast(bf16x8, w); } while (0)
    PK4(p0, 0, pa0); PK4(p0, 8, pa1); PK4(p1, 0, pa2); PK4(p1, 8, pa3);
#undef PK4
}
__device__ __forceinline__ float half_swap_max(float v) { auto rr = __builtin_amdgcn_permlane32_swap(__float_as_uint(v), __float_as_uint(v), false, false); return fmaxf(__uint_as_float(rr[0]), __uint_as_float(rr[1])); }
__device__ __forceinline__ float half_swap_sum(float v) { auto rr = __builtin_amdgcn_permlane32_swap(__float_as_uint(v), __float_as_uint(v), false, false); return __uint_as_float(rr[0]) + __uint_as_float(rr[1]); }

struct TileStage { bf16x8 k0, k1, v0, v1; };
__device__ __forceinline__ void tile_load(TileStage& T, const bf16_t* Kp, const bf16_t* Vp, int key0, int sr, int sc) {
    T.k0 = *(const bf16x8*)(Kp + (size_t)(key0 + sr) * HD + sc); T.k1 = *(const bf16x8*)(Kp + (size_t)(key0 + 32 + sr) * HD + sc);
    T.v0 = *(const bf16x8*)(Vp + (size_t)(key0 + sr) * HD + sc); T.v1 = *(const bf16x8*)(Vp + (size_t)(key0 + 32 + sr) * HD + sc);
}
__device__ __forceinline__ void tile_write(const TileStage& T, LAS unsigned char* lds, int kbuf, int vbuf, int sr, int sc) {
    const int kws = KSWZ(sr, sc * 2);
    *(LAS bf16x8*)(lds + AT_K + kbuf * SHM_T + kws) = T.k0; *(LAS bf16x8*)(lds + AT_K + kbuf * SHM_T + kws + 32 * 256) = T.k1;
    *(LAS bf16x8*)(lds + AT_V + vbuf * SHM_T + v_st(sr, sc)) = T.v0; *(LAS bf16x8*)(lds + AT_V + vbuf * SHM_T + v_st(32 + sr, sc)) = T.v1;
}

template <int MODE>
__device__ __forceinline__ void attn_branch(Frame& F, const bf16_t* Kp, const bf16_t* Vp, int j_lo, int j_hi, int sb, const bf16x8* qr, unsigned smask, f32x16* o, float& l_out) {
    int tid = F.tid; asm volatile("" : "+v"(tid));
    const int lane = tid & 63, wid = F.wave, r32 = lane & 31, hi = lane >> 5, hl = wid >> 1, rh = wid & 1;
    const int sr = tid >> 4, sc = (tid & 15) * 8;
    LAS unsigned char* lds = F.lds;
    LAS float* wsf = (LAS float*)(lds + AT_WS) + wid * 64;
    const LAS float* lut = (const LAS float*)(lds + AT_LUT) + hl * 304;
    const int vb0 = (int)(uintptr_t)(lds + AT_V) + v_rd_base(lane);
    const int qpos = 64 * sb + 32 * rh + r32;
    float m_reg = -1e30f, l_reg = 0.f;
#pragma unroll
    for (int d = 0; d < 4; ++d) o[d] = f32x16{};
    const int NT = j_hi - j_lo + 1;
    TileStage T;
    { TileStage T1; tile_load(T, Kp, Vp, j_lo * 64, sr, sc); if (NT > 1) tile_load(T1, Kp, Vp, (j_lo + 1) * 64, sr, sc);
      tile_write(T, lds, 0, 0, sr, sc); if (NT > 1) tile_write(T1, lds, 1, 1, sr, sc); }
    __syncthreads();
#define SEL_INIT(j_) ((MODE == 1) ? ((((smask >> (j_)) & 1u) != 0u) ? 0.f : -__builtin_inff()) : 0.f)
    int vs = 0;
    for (int t = 0; t < NT; ++t) {
        const int j = j_lo + t;
        f32x16 C0, C1;
        qkt(C0, C1, lds + AT_K + (t & 1) * SHM_T, r32, hi, qr, SEL_INIT(j));
        const int dq = qpos - 64 * j - 4 * hi;
        if (64 * (sb - j) + 32 * rh < 176) lut_add(C0, C1, lut + (dq + 37));
        if (j == sb || (MODE == 2 && j == sb - 8)) { const float NEG = -__builtin_inff(); const unsigned W = MODE == 2 ? 512u : 0x40000000u;
#pragma unroll
            for (int r = 0; r < 16; ++r) { const int c = (r & 3) + 8 * (r >> 2);
                if ((unsigned)(dq - c) >= W) C0[r] = NEG;
                if ((unsigned)(dq - c - 32) >= W) C1[r] = NEG; } }
        float pmax = fmaxf(C0[0], C1[0]);
#pragma unroll
        for (int r = 1; r < 16; ++r) pmax = __builtin_fmaxf(__builtin_fmaxf(pmax, C0[r]), C1[r]);
        pmax = half_swap_max(pmax);
        float alpha = 1.f;
        if (!__all(pmax - m_reg <= 6.0f)) { const float mn = fmaxf(m_reg, pmax); alpha = __builtin_amdgcn_exp2f(m_reg - mn); m_reg = mn;
            if (hi == 0) wsf[r32] = alpha;
            LDS_WAIT();
#pragma unroll
            for (int d = 0; d < 4; ++d)
#pragma unroll
                for (int r = 0; r < 16; ++r) o[d][r] *= wsf[crow(r, hi)]; }
        float ps = 0.f;
#pragma unroll
        for (int r = 0; r < 16; ++r) { C0[r] = __builtin_amdgcn_exp2f(C0[r] - m_reg); C1[r] = __builtin_amdgcn_exp2f(C1[r] - m_reg); ps += C0[r] + C1[r]; }
        ps = half_swap_sum(ps);
        l_reg = l_reg * alpha + ps;
        bf16x8 pa0, pa1, pa2, pa3; pack_p(C0, C1, pa0, pa1, pa2, pa3);
        if (t + 2 < NT) tile_load(T, Kp, Vp, (j + 2) * 64, sr, sc);
        SBAR();
        pv_tile(o, vb0 + vs * SHM_T, pa0, pa1, pa2, pa3);
        if (t + 2 < NT) tile_write(T, lds, t & 1, vs == 0 ? 2 : vs - 1, sr, sc);
        __syncthreads();
        vs = vs == 2 ? 0 : vs + 1;
    }
#undef SEL_INIT
    l_out = l_reg;
}
template <int MODE>
__device__ __forceinline__ void emit_scaled(const f32x16* o, float scl, LAS float* wsf, int r32, int hi, float* ya, bf16_t* yp) {
    if (hi == 0) wsf[r32] = scl;
    int oa = (4 * hi) * DATT + r32, ob = (4 * hi) * 64 + r32;
    asm volatile("" : "+v"(oa), "+v"(ob));
    float* yb = ya + oa; bf16_t* ypb = yp + ob;
    float prev[16][4];
    if (MODE >= 1) {
#pragma unroll
        for (int r = 0; r < 16; ++r) { const float* p = yb + (size_t)((r & 3) + 8 * (r >> 2)) * DATT;
#pragma unroll
            for (int d = 0; d < 4; ++d) prev[r][d] = p[d * 32]; }
    }
    LDS_WAIT();
    float sv[16];
#pragma unroll
    for (int r = 0; r < 16; ++r) sv[r] = wsf[crow(r, hi)];
    LDS_WAIT();
#pragma unroll
    for (int r = 0; r < 16; ++r) { const int orow = (r & 3) + 8 * (r >> 2);
        float* p = yb + (size_t)orow * DATT; bf16_t* q = ypb + (size_t)orow * 64;
#pragma unroll
        for (int d = 0; d < 4; ++d) { float v = o[d][r] * sv[r];
            if (MODE >= 1) v += prev[r][d];
            if (MODE <= 1) p[d * 32] = v;
            else { const float vn = __shfl_xor(v, 1); if ((r32 & 1) == 0) *(unsigned*)(q + (d >> 1) * (256 * 64) + (d & 1) * 32) = cvt_pk_bf16(v, vn); } } }
}

__device__ __forceinline__ int rel_bucket(int n) {
    if (n < 16) return n;
    int b = 16; const int thr[15] = {19, 21, 24, 27, 31, 35, 40, 46, 52, 59, 67, 77, 87, 99, 113};
#pragma unroll
    for (int i = 0; i < 15; ++i) b += (n >= thr[i]) ? 1 : 0;
    return b;
}

__device__ __forceinline__ void attn_unit(Frame& F, int b, int g, int sb) {
    int tid = F.tid; asm volatile("" : "+v"(tid));
    const int lane = tid & 63, wid = F.wave, r32 = lane & 31, hi = lane >> 5, hl = wid >> 1, rh = wid & 1;
    const int sr = tid >> 4, sc = (tid & 15) * 8;
    unsigned char* ws = F.ws; LAS unsigned char* lds = F.lds;
    LAS float* wsf = (LAS float*)(lds + AT_WS) + wid * 64;
    LAS float* lutw = (LAS float*)(lds + AT_LUT);
    LAS float* gl = (LAS float*)(lds + AT_GL);
    LAS unsigned* selm = (LAS unsigned*)(lds + AT_SEL);
    LAS float* impS = (LAS float*)(lds + AT_IMPS);
    LAS float* impH = (LAS float*)(lds + AT_IMPH);
    const int h = g * 4 + hl, bg = b * NG + g, row = 32 * rh + r32, pos = 64 * sb + row;
    const size_t kvs = KV_STRIDE_B / 2;
    const bf16_t* kvb = (const bf16_t*)(ws + WS_KV);
    const bf16_t* Ksel = kvb + 2 * kvs + (size_t)bg * SEQ * HD; const bf16_t* Vsel = kvb + 3 * kvs + (size_t)bg * SEQ * HD;
    const bf16_t* Kwin = kvb + 4 * kvs + (size_t)bg * SEQ * HD; const bf16_t* Vwin = kvb + 5 * kvs + (size_t)bg * SEQ * HD;
    const bf16_t* Kc = (const bf16_t*)(ws + WS_KCMP) + (size_t)bg * 128 * HD; const bf16_t* Vc = (const bf16_t*)(ws + WS_VCMP) + (size_t)bg * 128 * HD;
    __syncthreads();
    for (int i = tid; i < 4 * 304; i += 512) { const int hh = i / 304, ix = i % 304; int d = ix - 96; d = d < 0 ? 0 : (d > 127 ? 127 : d);
        const float* tab = INP(16); lutw[i] = (tab[rel_bucket(d) * NH + g * 4 + hh] - tab[31 * NH + g * 4 + hh]) * LOG2E; }
    for (int i = tid; i < 768; i += 512) { const int br = i >> 8, hh = (i >> 6) & 3, rw = i & 63; gl[i] = ((const float*)(ws + WS_GATES))[(size_t)(b * SEQ + 64 * sb + rw) * 48 + br * 16 + g * 4 + hh]; }
    if (tid < 64) selm[tid] = 0u;
    bf16x8 qr[8];
    { const bf16_t* qp = (const bf16_t*)(ws + WS_Q) + ((size_t)(b * NH + h) * SEQ + pos) * HD + hi * 8;
#pragma unroll
        for (int d0 = 0; d0 < 8; ++d0) qr[d0] = *(const bf16x8*)(qp + d0 * 16); }
    { TileStage T0, T1; tile_load(T0, Kc, Vc, 0, sr, sc); tile_load(T1, Kc, Vc, 64, sr, sc); tile_write(T0, lds, 0, 0, sr, sc); tile_write(T1, lds, 1, 1, sr, sc); }
    __syncthreads();
    f32x16 o[4];
    float* ya = (float*)(ws + WS_HID) + (size_t)(b * SEQ + 64 * sb + 32 * rh) * DATT + h * HD;
    bf16_t* yp = (bf16_t*)(ws + WS_YMIX) + blk_off(b * SEQ + 64 * sb + 32 * rh, h * HD, KT4);
    {
        f32x16 cA0, cA1, cB0, cB1;
        qkt(cA0, cA1, lds + AT_K, r32, hi, qr, 0.f);
        qkt(cB0, cB1, lds + AT_K + SHM_T, r32, hi, qr, 0.f);
        const LAS float* lut = lutw + hl * 304;
        const int dqc = pos - 31 - 64 * hi; const float NEG = -__builtin_inff();
        float mx = NEG;
#define CMP_FIX(P, CB) do { _Pragma("unroll") for (int r = 0; r < 16; ++r) { const int c = (CB) + (r & 3) + 8 * (r >> 2); const int dist = dqc - 16 * c; \
            int ix = dist + 96; ix = ix < 0 ? 0 : (ix > 303 ? 303 : ix); const float bv = lut[ix]; P[r] = dist >= 0 ? P[r] + bv : NEG; mx = fmaxf(mx, P[r]); } } while (0)
        CMP_FIX(cA0, 0); CMP_FIX(cA1, 32); CMP_FIX(cB0, 64); CMP_FIX(cB1, 96);
#undef CMP_FIX
        mx = half_swap_max(mx);
        const float mref = (mx == NEG) ? 0.f : mx;
        float ls = 0.f;
#pragma unroll
        for (int r = 0; r < 16; ++r) { cA0[r] = __builtin_amdgcn_exp2f(cA0[r] - mref); cA1[r] = __builtin_amdgcn_exp2f(cA1[r] - mref); cB0[r] = __builtin_amdgcn_exp2f(cB0[r] - mref); cB1[r] = __builtin_amdgcn_exp2f(cB1[r] - mref);
            ls += (cA0[r] + cA1[r]) + (cB0[r] + cB1[r]); }
        ls = half_swap_sum(ls);
        const float inv = ls > 0.f ? 1.0f / ls : 0.f;
#pragma unroll
        for (int r = 0; r < 16; ++r) { cA0[r] *= inv; cA1[r] *= inv; cB0[r] *= inv; cB1[r] *= inv; }
        LAS float* ih = impH + (hl * 64 + row) * 33;
        float lprev = 0.f;
#define IMP_Q(P, QB) do { _Pragma("unroll") for (int i = 0; i < 4; ++i) { const float Gq = (P[4 * i] + P[4 * i + 1]) + (P[4 * i + 2] + P[4 * i + 3]); const float Lq = P[4 * i + 3]; \
            auto rr = __builtin_amdgcn_permlane32_swap(__float_as_uint(Lq), __float_as_uint(Lq), false, false); \
            const float lp_lo = __uint_as_float(rr[0]), lp_hi = __uint_as_float(rr[1]); \
            ih[2 * ((QB) + i) + hi] = Gq + (hi ? lp_lo : lprev); lprev = lp_hi; } } while (0)
        IMP_Q(cA0, 0); IMP_Q(cA1, 4); IMP_Q(cB0, 8); IMP_Q(cB1, 12);
#undef IMP_Q
#pragma unroll
        for (int d = 0; d < 4; ++d) o[d] = f32x16{};
        const int vb0 = (int)(uintptr_t)(lds + AT_V) + v_rd_base(lane);
        { bf16x8 pa0, pa1, pa2, pa3; pack_p(cA0, cA1, pa0, pa1, pa2, pa3); SBAR(); pv_tile(o, vb0, pa0, pa1, pa2, pa3); }
        { bf16x8 pa0, pa1, pa2, pa3; pack_p(cB0, cB1, pa0, pa1, pa2, pa3); SBAR(); pv_tile(o, vb0 + SHM_T, pa0, pa1, pa2, pa3); }
        emit_scaled<0>(o, gl[0 * 256 + hl * 64 + row], wsf, r32, hi, ya, yp);
    }
    __syncthreads();
    {
        const int rw = tid >> 3, jg = tid & 7;
#pragma unroll
        for (int e = 0; e < 4; ++e) { const int j = 4 * jg + e; impS[rw * 33 + j] = (impH[(0 * 64 + rw) * 33 + j] + impH[(1 * 64 + rw) * 33 + j]) + (impH[(2 * 64 + rw) * 33 + j] + impH[(3 * 64 + rw) * 33 + j]); }
        __syncthreads();
        unsigned bits = 0u;
        if (sb <= 7) {
#pragma unroll
            for (int e = 0; e < 4; ++e) { const int j = 4 * jg + e; if (j <= sb) bits |= 1u << j; }
        } else {
            float v[32];
#pragma unroll
            for (int i = 0; i < 32; ++i) v[i] = impS[rw * 33 + i];
#pragma unroll
            for (int e = 0; e < 4; ++e) { const int j = 4 * jg + e; float vj = 0.f;
#pragma unroll
                for (int i = 0; i < 32; ++i) vj = (i == j) ? v[i] : vj;
                int rank = 0;
#pragma unroll
                for (int i = 1; i < 32; ++i) { const bool cand = i <= sb - 2; rank += (cand && (v[i] > vj || (v[i] == vj && i < j))) ? 1 : 0; }
                const bool candj = j >= 1 && j <= sb - 2;
                if ((candj && rank < 5) || j == 0 || j == sb || j == sb - 1) bits |= 1u << j; }
        }
        bits |= __shfl_xor(bits, 1); bits |= __shfl_xor(bits, 2); bits |= __shfl_xor(bits, 4);
        if (jg == 0) selm[rw] = bits;
    }
    __syncthreads();
    const unsigned smask = selm[row];
    float l2;
    attn_branch<1>(F, Ksel, Vsel, 0, sb, sb, qr, smask, o, l2);
    emit_scaled<1>(o, gl[1 * 256 + hl * 64 + row] / l2, wsf, r32, hi, ya, yp);
    float l3;
    attn_branch<2>(F, Kwin, Vwin, sb >= 8 ? sb - 8 : 0, sb, sb, qr, 0u, o, l3);
    emit_scaled<2>(o, gl[2 * 256 + hl * 64 + row] / l3, wsf, r32, hi, ya, yp);
}

constexpr int PER_PHASE = 10;
constexpr int N_LAUNCHES = MK_N_LAUNCHES;
struct Args { const float* in[22]; float* out; unsigned char* ws; int ph_lo, ph_hi, li, pad; };
__global__ void __launch_bounds__(512, 2) mk_fwd(Args args) {
    extern __shared__ __attribute__((aligned(16))) unsigned char lds_raw[];
    Frame F;
    F.lds = (LAS unsigned char*)lds_raw;
    F.tid = threadIdx.x; F.wave = __builtin_amdgcn_readfirstlane(F.tid >> 6);
    F.G = gridDim.x; { const int bx = blockIdx.x; F.vcu = (F.G % 8 == 0) ? (bx % 8) * (F.G / 8) + bx / 8 : bx; }
    F.out = args.out; F.ws = args.ws;
    unsigned char* ws = args.ws;
    volatile LAS unsigned* MISC = (volatile LAS unsigned*)(F.lds + MISC_OFF);
    for (int u = F.tid; u < (LDS_BYTES - CTRL_OFF) / 4; u += 512) ((LAS unsigned*)(F.lds + CTRL_OFF))[u] = 0u;
    __syncthreads();
    if (F.tid < 22) *(LAS u64*)(F.lds + PTR_OFF + 8 * F.tid) = (u64)(uintptr_t)args.in[F.tid];
    __syncthreads();
    unsigned* ctl = (unsigned*)(ws + WS_CTL);
    XcdBarrier bar; bar.bar = ctl + CW_BAR + args.li * XCD_BAR_WORDS; bar.x = 0; bar.st = nullptr;
    if (N_LAUNCHES != PER_PHASE) bar = xcd_barrier_post(ctl + CW_BAR + args.li * XCD_BAR_WORDS, MISC + 8);
    const int lo = args.ph_lo, hi = args.ph_hi;
#ifndef PH_MASK
#define PH_MASK 0x3ff
#endif
#define IN(k) (((PH_MASK >> (k)) & 1) && lo <= (k) && (k) < hi)
#define BOTH(k) (IN(k) && IN((k) + 1))
#define GRID_BAR() do { if (N_LAUNCHES != PER_PHASE) xcd_barrier(bar); } while (0)
    u64* racc1 = (u64*)(ws + WS_CTL + CTL_RACC); u64* racc2 = racc1 + M; u64* racc3 = racc2 + M;
    bf16_t* actb = (bf16_t*)(ws + WS_ACTB); bf16_t* hid = (bf16_t*)(ws + WS_HID);

    static_assert(N_LAUNCHES == 1, "phases 0 and 6 contain an in-phase grid barrier");
    if (IN(0)) { gu_absmax<ROT2>(F, GU_STRIPS, GU_STRIPS_ALL); gu_absmax<ROT1>(F, GU_STRIPS_ALL, GU_STRIPS_ALL + 1408); gu_absmax<0>(F, 2752, GU_STRIPS); GRID_BAR(); p0_prologue(F); if (BOTH(0)) GRID_BAR(); }

    if (IN(1)) {
        pg8::Gemm g{ws + WS_XQ, ws + WS_WGU1, DM, 1}; pg8::StaticOrder S; S.init(M, NGU, F.G, (int)blockIdx.x);
        EpiSwiGLUQ<false> E{hid, (const float*)(ws + WS_SMALL + SM_RA0), (const float*)(ws + WS_SMALL + SM_SB1), nullptr};
        pg8::gemm_phase<EpiSwiGLUQ<false>, pg8::StaticOrder, true>(F.lds, g, S, E);
        { const int r = S.nwg % F.G;
          if ((int)blockIdx.x == r && F.tid < 256) { const int kv = F.tid >> 7, n = F.tid & 127; const float* pb = (const float*)(ws + WS_SMALL + SM_PBP) + (size_t)kv * 128 * 128 + n;
              float sacc = 0.f; for (int ch = 0; ch < 128; ++ch) sacc += pb[ch * 128];
              ((float*)(ws + WS_CTL + CTL_PBSUM))[kv * 128 + n] = sacc; } }
        tail_quant<ROT1>(F, S.nwg, Q_R_D1Q + 5408, Q_R_D1Q + P0_I_D);
        GRID_BAR();
        quant_hid_rot<ROT1>(F, hid, ws + WS_HIDQ, (float*)(ws + WS_SMALL + SM_SH));
        if (BOTH(1)) GRID_BAR();
    }
    if (IN(2)) {
        pg8::Gemm g{ws + WS_HIDQ, ws + WS_WD1, FF, 1}; pg8::StaticOrder S; S.init(M, DM, F.G, (int)blockIdx.x);
        EpiResidQ E{INP(0), F.out, racc1, (const float*)(ws + WS_SMALL + SM_SH), (const float*)(ws + WS_SMALL + SM_SB4), 0.5f, actb};
        pg8::gemm_phase<EpiResidQ, pg8::StaticOrder, true>(F.lds, g, S, E);
        if (BOTH(2)) GRID_BAR();
    }
    if (IN(3)) {
        pg8::Gemm g{actb, ws + WS_WIN, DM, 2}; pg8::StaticOrder S; S.init(M, NINP, F.G, (int)blockIdx.x);
        EpiWin E{(bf16_t*)(ws + WS_Q), (bf16_t*)(ws + WS_KV), (float*)(ws + WS_U), (float*)(ws + WS_GATES), racc1, KV_STRIDE_B / 2};
        pg8::gemm_phase(F.lds, g, S, E);
        tail_convert(F, S.nwg, P0_R_OUT, P0_R_SMALL);
        tail_quant<ROT2>(F, S.nwg, Q_R_D2 + 1708, Q_R_D2 + 5408);
        tail_quant(F, S.nwg, P0_R_GU2, P0_R_GU2 + 7500);
        if (PROBE_DUP == 3) { GRID_BAR(); pg8::gemm_phase(F.lds, g, S, E); }
        if (BOTH(3)) GRID_BAR();
    }
    if (IN(4)) {
        for (int u = blockIdx.x; u < 128; u += F.G) compress_unit(F, u >> 6, u & 63);
        for (int u = blockIdx.x; u < 256; u += F.G) pool_d_unit(F, u);
        __syncthreads();
        if (F.G > 128) { if ((int)blockIdx.x >= 128) gu_quant(F, P0_R_GU2 + 7500, P0_R_D1, (int)blockIdx.x - 128, F.G - 128); }
        else gu_quant(F, P0_R_GU2 + 7500, P0_R_D1, (int)blockIdx.x, F.G);
        if (PROBE_DUP == 4) { GRID_BAR(); for (int u = blockIdx.x; u < 128; u += F.G) compress_unit(F, u >> 6, u & 63); for (int u = blockIdx.x; u < 256; u += F.G) pool_d_unit(F, u); }
        if (BOTH(4)) GRID_BAR();
    }
    if (IN(5)) {
        { pg8::Gemm g{ws + WS_DPOOL, ws + WS_SMALL + SM_WPOOL, 512, 2}; pg8::PoolOrder S{F.G, (int)blockIdx.x};
          EpiPool E{(bf16_t*)(ws + WS_YMIX), INP(14)};
          pg8::gemm_phase(F.lds, g, S, E); }
        for (int u = blockIdx.x; u < 256; u += F.G) {
            const int x = u & 7, k = u >> 3, bg = 2 * x + (k & 1), pr = k >> 1;
            attn_unit(F, bg >> 2, bg & 3, 31 - pr);
            attn_unit(F, bg >> 2, bg & 3, pr);
        }
        if (PROBE_DUP == 5) { GRID_BAR(); for (int u = blockIdx.x; u < 256; u += F.G) { const int x = u & 7, k = u >> 3, bg = 2 * x + (k & 1), pr = k >> 1; attn_unit(F, bg >> 2, bg & 3, 31 - pr); attn_unit(F, bg >> 2, bg & 3, pr); } }
        if (BOTH(5)) GRID_BAR();
    }
    if (IN(6)) {
        pg8::Gemm g{ws + WS_YMIX, ws + WS_WOUT, DM, 2}; pg8::StaticOrder S; S.init(M, DM, F.G, (int)blockIdx.x);
        EpiResid E{F.out, F.out, nullptr, nullptr, 1.0f};
        pg8::gemm_phase(F.lds, g, S, E);
        GRID_BAR();
        quant_rows(F, F.out, ws + WS_XQ, (float*)(ws + WS_SMALL + SM_RA2));
        if (BOTH(6)) GRID_BAR();
    }
    if (IN(7)) {
        pg8::Gemm g{ws + WS_XQ, ws + WS_WGU2, DM, 1}; pg8::StaticOrder S; S.init(M, NGU, F.G, (int)blockIdx.x);
        EpiSwiGLUQ<false> E{hid, (const float*)(ws + WS_SMALL + SM_RA2), (const float*)(ws + WS_SMALL + SM_SB2), nullptr};
        pg8::gemm_phase<EpiSwiGLUQ<false>, pg8::StaticOrder, true>(F.lds, g, S, E);
        tail_quant<ROT2>(F, S.nwg, Q_R_D2 + 5408, Q_R_D2 + P0_I_D);
        GRID_BAR();
        quant_hid_rot<ROT2>(F, hid, ws + WS_HIDQ, (float*)(ws + WS_SMALL + SM_SH));
        if (BOTH(7)) GRID_BAR();
    }
    if (IN(8)) {
        pg8::Gemm g{ws + WS_HIDQ, ws + WS_WD2, FF, 1}; pg8::StaticOrder S; S.init(M, DM, F.G, (int)blockIdx.x);
        EpiResidQ E{F.out, nullptr, racc3, (const float*)(ws + WS_SMALL + SM_SH), (const float*)(ws + WS_SMALL + SM_SB3), 0.5f, actb};
        pg8::gemm_phase<EpiResidQ, pg8::StaticOrder, true>(F.lds, g, S, E);
        if (BOTH(8)) GRID_BAR();
    }
    if (IN(9)) {
        const int gw = F.vcu * 8 + F.wave, NGW = F.G * 8, lane = (F.tid & 63), kq = lane >> 3, c = lane & 7;
        const float* gn = INP(21);
        for (int m = gw; m < M; m += NGW) {
            const float r = rs_from_acc(racc3[m]);
            const bf16_t* src = actb + blk_off(m, 64 * kq, KT4) + 8 * c;
            u32x4 v[8];
#pragma unroll
            for (int j = 0; j < 8; ++j) v[j] = *(const u32x4*)(src + (size_t)(8 * j) * (256 * 64));
#pragma unroll
            for (int j = 0; j < 8; ++j) {
                const int k = 64 * (8 * j + kq) + 8 * c;
                const f32x4 g0 = *(const f32x4*)(gn + k), g1 = *(const f32x4*)(gn + k + 4);
                f32x4 o0, o1;
                o0[0] = __uint_as_float(v[j].x << 16); o0[1] = __uint_as_float(v[j].x & 0xffff0000u); o0[2] = __uint_as_float(v[j].y << 16); o0[3] = __uint_as_float(v[j].y & 0xffff0000u);
                o1[0] = __uint_as_float(v[j].z << 16); o1[1] = __uint_as_float(v[j].z & 0xffff0000u); o1[2] = __uint_as_float(v[j].w << 16); o1[3] = __uint_as_float(v[j].w & 0xffff0000u);
                float* dst = F.out + (size_t)m * DM + k;
                *(f32x4*)dst = o0 * r * g0; *(f32x4*)(dst + 4) = o1 * r * g1;
            }
        }
    }
#undef IN
#undef BOTH
#undef GRID_BAR
}

extern "C" void kernel_launch(void* const* d_in, const int* in_sizes, int n_in, void* d_out, int out_size, void* d_ws, size_t ws_size, hipStream_t stream) {
    static int grid = 0;
    if (grid == 0) {
        if (n_in != 22 || in_sizes[0] != M * DM || out_size != M * DM || ws_size < WS_END3) { fprintf(stderr, "kernel_launch: unexpected shapes (n_in %d, in0 %d, out %d, ws %zu < %zu); nothing launched\n", n_in, n_in > 0 ? in_sizes[0] : -1, out_size, ws_size, (size_t)WS_END3); grid = -1; return; }
        int dev = 0, cus = 0, per_cu = 0;
        if (hipGetDevice(&dev) != hipSuccess || hipDeviceGetAttribute(&cus, hipDeviceAttributeMultiprocessorCount, dev) != hipSuccess) { grid = -1; return; }
        if (hipFuncSetAttribute((const void*)mk_fwd, hipFuncAttributeMaxDynamicSharedMemorySize, LDS_BYTES) != hipSuccess) { fprintf(stderr, "kernel_launch: hipFuncSetAttribute failed\n"); grid = -1; return; }
        if (hipOccupancyMaxActiveBlocksPerMultiprocessor(&per_cu, (const void*)mk_fwd, 512, LDS_BYTES) != hipSuccess || per_cu < 1) fprintf(stderr, "kernel_launch: occupancy query says %d\n", per_cu);
        (void)hipGetLastError();
        grid = cus;
    }
    if (grid < 0) return;
    if (hipMemsetAsync((char*)d_ws + WS_CTL, 0, CTL_ZERO_BYTES, stream) != hipSuccess) { fprintf(stderr, "kernel_launch: memset failed\n"); return; }
    Args a{};
    for (int i = 0; i < 22; ++i) a.in[i] = (const float*)d_in[i];
    a.out = (float*)d_out; a.ws = (unsigned char*)d_ws;
    for (int li = 0; li < N_LAUNCHES; ++li) {
        if (N_LAUNCHES == PER_PHASE) { a.ph_lo = li; a.ph_hi = li + 1; a.li = 0; }
        else { a.ph_lo = li * PER_PHASE / N_LAUNCHES; a.ph_hi = (li + 1) * PER_PHASE / N_LAUNCHES; a.li = li; }
        hipLaunchKernelGGL(mk_fwd, dim3(grid), dim3(512), LDS_BYTES, stream, a);
        const hipError_t le = hipPeekAtLastError();
        if (le != hipSuccess) { fprintf(stderr, "kernel_launch: launch %d failed: %s\n", li, hipGetErrorName(le)); break; }
    }
}
```

```cpp
#include <hip/hip_runtime.h>
#include <cstdio>
#include <cstdint>

#ifndef MK_N_LAUNCHES
#define MK_N_LAUNCHES 1
#endif
#ifndef PROBE_DUP
#define PROBE_DUP -1
#endif

#define LAS __attribute__((address_space(3)))
#define GAS __attribute__((address_space(1)))
typedef unsigned short bf16_t;
typedef short bf16x8 __attribute__((ext_vector_type(8)));
typedef short s16x4 __attribute__((ext_vector_type(4)));
typedef float f32x4 __attribute__((ext_vector_type(4)));
typedef float f32x16 __attribute__((ext_vector_type(16)));
typedef unsigned u32x4 __attribute__((ext_vector_type(4)));
typedef unsigned u32x2 __attribute__((ext_vector_type(2)));
typedef int i32x4 __attribute__((ext_vector_type(4)));
typedef unsigned long long u64;

constexpr int BATCH = 4, SEQ = 2048, DM = 4096, FF = 11008, NGU = 2 * FF, M = BATCH * SEQ;
constexpr int NH = 16, NG = 4, HD = 128, DATT = 2048, DKV = 512, DPOOL = 2048;
__host__ __device__ __forceinline__ size_t blk_off(int r, int k, int KT) { return ((size_t)((r >> 8) * KT + (k >> 6)) * 256 + (size_t)(r & 255)) * 64 + (size_t)(k & 63); }
constexpr int KT4 = DM / 64, KTF = FF / 64, KTP = 512 / 64;
__host__ __device__ __forceinline__ size_t blk8_off(int r, int k, int KT8_) { return ((size_t)((r >> 8) * KT8_ + (k >> 7)) * 256 + (size_t)(r & 255)) * 128 + (size_t)(k & 127); }
constexpr int KT8 = DM / 128;
constexpr int NIN = 7216, NINP = 7424;
constexpr float EPS = 1e-6f;
constexpr float LOG2E = 1.4426950408889634f;
constexpr float QSCALE = 0.08838834764831845f * LOG2E;

__device__ __forceinline__ unsigned cvt_pk_bf16(float lo, float hi) { unsigned r; asm volatile("v_cvt_pk_bf16_f32 %0, %1, %2" : "=v"(r) : "v"(lo), "v"(hi)); return r; }
__device__ __forceinline__ float rs_from_acc(u64 a) { return __builtin_amdgcn_rsqf((float)a * (1.0f / (4294967296.0f * 4096.0f)) + EPS); }

namespace pg8 {
constexpr int BM = 256, BK = 64, HALF = 128, HTB = HALF * BK * 2, STAGE_BYTES = 8 * HTB, NXCD = 8, WGM = 4;
__host__ __device__ __forceinline__ int lds_byte(int r, int c) { const int st = (r >> 4) * 2 + (c >> 5), rr = r & 15, cc = c & 31, ob = rr * 64 + cc * 2; return st * 1024 + (ob ^ (((ob >> 9) & 1) << 5)); }
__host__ __device__ __forceinline__ void stage_rc(int b, int& R, int& C) { const int st = b / 1024, sb = b % 1024, swz = sb ^ (((sb >> 9) & 1) << 5); R = (st >> 1) * 16 + swz / 64; C = (st & 1) * 32 + (swz % 64) / 2; }
__host__ __device__ __forceinline__ int perm32(int rho) { const int n = rho >> 4, i = rho & 15; return 8 * (i >> 2) + 4 * n + (i & 3); }

struct Unit { int pm, pn, g; };
struct Gemm { const void* A; const void* Bt; int K, esz; };

struct StaticOrder {
    int nM, nN, nwg, G, c;
    __device__ void init(int M_, int N_, int G_, int c_) { nM = M_ / BM; nN = N_ / BM; nwg = nM * nN; G = G_; c = c_; }
    __device__ bool next(int i, Unit& u) const {
        const long L = (long)i * G + c; if (L >= nwg) return false;
        int wgid = (int)L; { const int q = nwg / NXCD, r = nwg % NXCD, xcd = wgid % NXCD, off = wgid / NXCD; wgid = (xcd < r ? xcd * (q + 1) : r * (q + 1) + (xcd - r) * q) + off; }
        const int nig = WGM * nN, gid = wgid / nig, fm = gid * WGM, gsz = (nM - fm) < WGM ? (nM - fm) : WGM;
        u.pm = fm + ((wgid % nig) % gsz); u.pn = (wgid % nig) / gsz; u.g = 0; return true;
    }
    __device__ __forceinline__ size_t aoff(const Unit& u, const Gemm& g) const { return (size_t)u.pm * BM * g.K * g.esz; }
    __device__ __forceinline__ size_t boff(const Unit& u, const Gemm& g) const { return (size_t)u.pn * BM * g.K * g.esz; }
};
struct PoolOrder {
    int G, c;
    __device__ bool next(int i, Unit& u) const { const int L = i * G + c; if (L >= 256) return false; u.g = L >> 6; const int r = L & 63; u.pm = r >> 1; u.pn = r & 1; return true; }
    __device__ __forceinline__ size_t aoff(const Unit& u, const Gemm& g) const { return (size_t)(u.g * 32 + u.pm) * BM * g.K * g.esz; }
    __device__ __forceinline__ size_t boff(const Unit& u, const Gemm& g) const { return (size_t)(u.g * 2 + u.pn) * BM * g.K * g.esz; }
};

template <class Epi, class Sched, bool I8 = false>
__device__ __forceinline__ void gemm_phase(LAS unsigned char* lds, const Gemm g, const Sched& S, const Epi& E) {
    const int tid = threadIdx.x, wid = __builtin_amdgcn_readfirstlane(tid >> 6), lane = tid & 63, wr = wid >> 2, wc = wid & 3, fr = lane & 15, fq = lane >> 4;
    const int nt = g.K * g.esz / (BK * 2);
    unsigned voffA[2], voffB[2];
#pragma unroll
    for (int i = 0; i < 2; ++i) { int R, C; stage_rc(tid * 16 + i * 8192, R, C); const int Rb = Epi::PERM ? ((R & ~31) + perm32(R & 31)) : R;
        voffA[i] = (unsigned)(R * 64 + C) * 2u; voffB[i] = (unsigned)(Rb * 64 + C) * 2u; }
    const size_t kstep = (size_t)(BM * BK * 2);
    const size_t hstepA = (size_t)HALF * BK * 2, hstepB = (size_t)HALF * BK * 2;
    const unsigned ldsw = (unsigned)wid * 1024u;
    const int aoff = lds_byte(wr * 64 + fr, fq * 8), boff = lds_byte(wc * 32 + fr, fq * 8);
#define PG8_SA(b, h) (((b) * 2 + (h)) * HTB)
#define PG8_SB(b, h) ((4 + (b) * 2 + (h)) * HTB)
#define PG8_STAGE(bufoff, gbase, voff) do { _Pragma("unroll") for (int _i = 0; _i < 2; ++_i) \
        __builtin_amdgcn_global_load_lds((const unsigned*)((const char*)(gbase) + (voff)[_i]), (LAS unsigned*)(lds + (bufoff) + ldsw + _i * 8192), 16, 0, 0); } while (0)
#define PG8_LDA(dst, b, h) do { _Pragma("unroll") for (int m = 0; m < 4; ++m) _Pragma("unroll") for (int k = 0; k < 2; ++k) dst[m][k] = *(const LAS bf16x8*)(lds + PG8_SA(b, h) + aoff + m * 2048 + k * 1024); } while (0)
#define PG8_LDB(dst, b, h) do { _Pragma("unroll") for (int n = 0; n < 2; ++n) _Pragma("unroll") for (int k = 0; k < 2; ++k) dst[n][k] = *(const LAS bf16x8*)(lds + PG8_SB(b, h) + boff + n * 2048 + k * 1024); } while (0)
#define PG8_MMA(ai, bj, At, Bt) do { __builtin_amdgcn_s_setprio(1); _Pragma("unroll") for (int m = 0; m < 4; ++m) _Pragma("unroll") for (int n = 0; n < 2; ++n) _Pragma("unroll") for (int k = 0; k < 2; ++k) { \
        if constexpr (I8) acc[ai][bj][m][n] = __builtin_bit_cast(acc_t, __builtin_amdgcn_mfma_i32_16x16x64_i8(__builtin_bit_cast(i32x4, Bt[n][k]), __builtin_bit_cast(i32x4, At[m][k]), __builtin_bit_cast(i32x4, acc[ai][bj][m][n]), 0, 0, 0)); \
        else acc[ai][bj][m][n] = __builtin_bit_cast(acc_t, __builtin_amdgcn_mfma_f32_16x16x32_bf16(Bt[n][k], At[m][k], __builtin_bit_cast(f32x4, acc[ai][bj][m][n]), 0, 0, 0)); } __builtin_amdgcn_s_setprio(0); } while (0)
#define PG8_WAIT_V(n) asm volatile("s_waitcnt vmcnt(" #n ")" ::: "memory")
#define PG8_WAIT_L(n) asm volatile("s_waitcnt lgkmcnt(" #n ")" ::: "memory")
#define PG8_BAR __builtin_amdgcn_s_barrier()
#define PG8_SCHED __builtin_amdgcn_sched_barrier(0)
    Unit cur, nxt; int ui = 0;
    if (!S.next(0, cur)) return;
    typedef typename Epi::acc_t acc_t;
    acc_t acc[2][2][4][2];
#pragma unroll
    for (int a = 0; a < 2; ++a)
#pragma unroll
        for (int b = 0; b < 2; ++b)
#pragma unroll
            for (int m = 0; m < 4; ++m)
#pragma unroll
                for (int n = 0; n < 2; ++n) acc[a][b][m][n] = acc_t{};
    bf16x8 At[4][2], B0[2][2], B1[2][2];
    const char* cA = (const char*)g.A + S.aoff(cur, g); const char* cB = (const char*)g.Bt + S.boff(cur, g);
    PG8_STAGE(PG8_SB(0, 0), cB, voffB); PG8_STAGE(PG8_SB(0, 1), cB + hstepB, voffB); PG8_STAGE(PG8_SA(0, 0), cA, voffA); PG8_STAGE(PG8_SA(0, 1), cA + hstepA, voffA);
    if (wr == 1) PG8_BAR;
    PG8_WAIT_V(2); PG8_BAR;
    PG8_STAGE(PG8_SB(1, 0), cB + kstep, voffB); PG8_STAGE(PG8_SA(1, 0), cA + kstep, voffA); PG8_STAGE(PG8_SB(1, 1), cB + hstepB + kstep, voffB);
    PG8_WAIT_V(6); PG8_BAR;
    for (;;) {
        const bool has_next = S.next(ui + 1, nxt);
        const char* nA = has_next ? (const char*)g.A + S.aoff(nxt, g) : cA; const char* nB = has_next ? (const char*)g.Bt + S.boff(nxt, g) : cB;
        for (int t = 0; t < nt; t += 2) {
            const bool last = (t == nt - 2);
            const char* a1 = cA + (size_t)(t + 1) * kstep;
            const char* a2 = last ? nA : cA + (size_t)(t + 2) * kstep; const char* b2 = last ? nB : cB + (size_t)(t + 2) * kstep;
            const char* a3 = a2 + kstep; const char* b3 = b2 + kstep;
            PG8_LDB(B0, 0, 0); PG8_LDB(B1, 0, 1); PG8_SCHED; PG8_LDA(At, 0, 0); PG8_STAGE(PG8_SA(1, 1), a1 + hstepA, voffA);
            PG8_WAIT_V(8); PG8_WAIT_L(0); PG8_BAR; PG8_MMA(0, 0, At, B0); PG8_MMA(0, 1, At, B1); PG8_BAR; PG8_SCHED;
            PG8_LDA(At, 0, 1); PG8_STAGE(PG8_SB(0, 0), b2, voffB); PG8_STAGE(PG8_SB(0, 1), b2 + hstepB, voffB); PG8_STAGE(PG8_SA(0, 0), a2, voffA);
            PG8_WAIT_V(8); PG8_WAIT_L(0); PG8_BAR; PG8_MMA(1, 0, At, B0); PG8_MMA(1, 1, At, B1); PG8_BAR; PG8_SCHED;
            PG8_LDB(B0, 1, 0); PG8_LDB(B1, 1, 1); PG8_SCHED; PG8_LDA(At, 1, 0); PG8_STAGE(PG8_SA(0, 1), a2 + hstepA, voffA);
            PG8_WAIT_V(8); PG8_WAIT_L(0); PG8_BAR; PG8_MMA(0, 0, At, B0); PG8_MMA(0, 1, At, B1); PG8_BAR; PG8_SCHED;
            PG8_LDA(At, 1, 1); PG8_STAGE(PG8_SB(1, 0), b3, voffB); PG8_STAGE(PG8_SB(1, 1), b3 + hstepB, voffB); PG8_STAGE(PG8_SA(1, 0), a3, voffA);
            PG8_WAIT_V(8); PG8_WAIT_L(0); PG8_BAR; PG8_MMA(1, 0, At, B0); PG8_MMA(1, 1, At, B1); PG8_BAR; PG8_SCHED;
        }
        if (wr == 0) PG8_BAR;
        E(acc, cur, wr, wc, fr, fq);
        if (!has_next) break;
#pragma unroll
        for (int a = 0; a < 2; ++a)
#pragma unroll
            for (int b = 0; b < 2; ++b)
#pragma unroll
                for (int m = 0; m < 4; ++m)
#pragma unroll
                    for (int n = 0; n < 2; ++n) acc[a][b][m][n] = acc_t{};
        cur = nxt; cA = nA; cB = nB; ++ui;
        if (wr == 1) PG8_BAR;
    }
    PG8_WAIT_V(0);
    PG8_BAR;
#undef PG8_SA
#undef PG8_SB
#undef PG8_STAGE
#undef PG8_LDA
#undef PG8_LDB
#undef PG8_MMA
#undef PG8_WAIT_V
#undef PG8_WAIT_L
#undef PG8_BAR
#undef PG8_SCHED
}
}

__device__ __forceinline__ float silu_mul(float g, float u) { return g * u * __builtin_amdgcn_rcpf(1.0f + __builtin_amdgcn_exp2f(-g * LOG2E)); }

template <bool R64> struct EpiSwiGLU {
    static constexpr bool PERM = true; typedef f32x4 acc_t;
    bf16_t* O; const void* rs;
    __device__ __forceinline__ void operator()(const f32x4 (&acc)[2][2][4][2], const pg8::Unit& u, int wr, int wc, int fr, int fq) const {
        const int row0 = u.pm * 256 + wr * 64 + fr, col0 = u.pn * 128 + wc * 32 + 8 * fq;
        float rr[2][4];
#pragma unroll
        for (int ai = 0; ai < 2; ++ai)
#pragma unroll
            for (int m = 0; m < 4; ++m) { const int row = row0 + ai * 128 + m * 16; rr[ai][m] = R64 ? rs_from_acc(((const u64*)rs)[row]) : ((const float*)rs)[row]; }
#pragma unroll
        for (int ai = 0; ai < 2; ++ai)
#pragma unroll
            for (int m = 0; m < 4; ++m) {
                const int row = row0 + ai * 128 + m * 16;
                const float r = rr[ai][m];
                const f32x4 g0 = acc[ai][0][m][0] * r, g1 = acc[ai][0][m][1] * r, u0 = acc[ai][1][m][0] * r, u1 = acc[ai][1][m][1] * r;
                u32x4 w;
                w.x = cvt_pk_bf16(silu_mul(g0[0], u0[0]), silu_mul(g0[1], u0[1])); w.y = cvt_pk_bf16(silu_mul(g0[2], u0[2]), silu_mul(g0[3], u0[3]));
                w.z = cvt_pk_bf16(silu_mul(g1[0], u1[0]), silu_mul(g1[1], u1[1])); w.w = cvt_pk_bf16(silu_mul(g1[2], u1[2]), silu_mul(g1[3], u1[3]));
                *(u32x4*)(O + blk_off(row, col0, KTF)) = w;
            }
    }
};
__device__ __forceinline__ float bfly8(float x, bool up) { const float p = __uint_as_float(__builtin_amdgcn_update_dpp(0u, __float_as_uint(x), 0x128, 0xf, 0xf, false)); return up ? p - x : x + p; }
__device__ __forceinline__ float bfly16(float x, bool up) { const auto r = __builtin_amdgcn_permlane16_swap(__float_as_uint(x), __float_as_uint(x), false, false); const float a = __uint_as_float(r[0]), b = __uint_as_float(r[1]); return up ? a - b : a + b; }
__device__ __forceinline__ float bfly32(float x, bool up) { const auto r = __builtin_amdgcn_permlane32_swap(__float_as_uint(x), __float_as_uint(x), false, false); const float a = __uint_as_float(r[0]), b = __uint_as_float(r[1]); return up ? a - b : a + b; }
template <bool ROT>
struct EpiSwiGLUQ {
    static constexpr bool PERM = true; typedef i32x4 acc_t;
    bf16_t* O; const float* ra; const float* sb; unsigned* rmax;
    __device__ __forceinline__ void operator()(const i32x4 (&acc)[2][2][4][2], const pg8::Unit& u, int wr, int wc, int fr, int fq) const {
        const int row0 = u.pm * 256 + wr * 64 + fr, col0 = u.pn * 128 + wc * 32 + 8 * fq, ch0 = u.pn * 256 + wc * 32 + 8 * fq;
        const f32x4 sg0 = *(const f32x4*)(sb + ch0), sg1 = *(const f32x4*)(sb + ch0 + 4), su0 = *(const f32x4*)(sb + ch0 + 128), su1 = *(const f32x4*)(sb + ch0 + 132);
        float rr[2][4];
#pragma unroll
        for (int ai = 0; ai < 2; ++ai)
#pragma unroll
            for (int m = 0; m < 4; ++m) rr[ai][m] = ra[row0 + ai * 128 + m * 16];
#pragma unroll
        for (int ai = 0; ai < 2; ++ai)
#pragma unroll
            for (int m = 0; m < 4; ++m) {
                const int row = row0 + ai * 128 + m * 16; const float r = rr[ai][m];
                typedef float f32x2_t __attribute__((ext_vector_type(2)));
                const f32x2_t r2 = {r, r}, nl2 = {-LOG2E, -LOG2E}, one2 = {1.0f, 1.0f};
                float hh[8];
#pragma unroll
                for (int n = 0; n < 2; ++n)
#pragma unroll
                    for (int p = 0; p < 2; ++p) {
                        const f32x4 sgv = n ? sg1 : sg0, suv = n ? su1 : su0;
                        const f32x2_t a2 = {(float)acc[ai][0][m][n][2 * p], (float)acc[ai][0][m][n][2 * p + 1]}, b2 = {(float)acc[ai][1][m][n][2 * p], (float)acc[ai][1][m][n][2 * p + 1]};
                        const f32x2_t sg2 = {sgv[2 * p], sgv[2 * p + 1]}, su2 = {suv[2 * p], suv[2 * p + 1]};
                        const f32x2_t g2 = a2 * (r2 * sg2), u2 = b2 * (r2 * su2);
                        const f32x2_t t2 = g2 * nl2;
                        f32x2_t d2 = {__builtin_amdgcn_exp2f(t2.x), __builtin_amdgcn_exp2f(t2.y)};
                        d2 = d2 + one2;
                        d2 = (f32x2_t){__builtin_amdgcn_rcpf(d2.x), __builtin_amdgcn_rcpf(d2.y)};
                        const f32x2_t h2v = (g2 * u2) * d2;
                        hh[4 * n + 2 * p] = h2v.x; hh[4 * n + 2 * p + 1] = h2v.y;
                    }
                float h0 = hh[0], h1 = hh[1], h2 = hh[2], h3 = hh[3], h4 = hh[4], h5 = hh[5], h6 = hh[6], h7 = hh[7];
                if (ROT) {
#define FW_BF(a, b) { const float t_ = a; a = t_ + b; b = t_ - b; }
                    FW_BF(h0, h1) FW_BF(h2, h3) FW_BF(h4, h5) FW_BF(h6, h7)
                    FW_BF(h0, h2) FW_BF(h1, h3) FW_BF(h4, h6) FW_BF(h5, h7)
                    FW_BF(h0, h4) FW_BF(h1, h5) FW_BF(h2, h6) FW_BF(h3, h7)
#undef FW_BF
#define FW_X(h, L, sgn) { h = (L == 16) ? bfly16(h, sgn) : bfly32(h, sgn); }
                    { const bool s16 = (fq & 1) != 0, s32 = (fq & 2) != 0;
                      FW_X(h0, 16, s16) FW_X(h1, 16, s16) FW_X(h2, 16, s16) FW_X(h3, 16, s16) FW_X(h4, 16, s16) FW_X(h5, 16, s16) FW_X(h6, 16, s16) FW_X(h7, 16, s16)
                      FW_X(h0, 32, s32) FW_X(h1, 32, s32) FW_X(h2, 32, s32) FW_X(h3, 32, s32) FW_X(h4, 32, s32) FW_X(h5, 32, s32) FW_X(h6, 32, s32) FW_X(h7, 32, s32) }
#undef FW_X
                    const float sc = 0.17677669529663687f;
                    h0 *= sc; h1 *= sc; h2 *= sc; h3 *= sc; h4 *= sc; h5 *= sc; h6 *= sc; h7 *= sc;
                }
                u32x4 w;
                w.x = cvt_pk_bf16(h0, h1); w.y = cvt_pk_bf16(h2, h3); w.z = cvt_pk_bf16(h4, h5); w.w = cvt_pk_bf16(h6, h7);
                *(u32x4*)(O + blk_off(row, col0, KTF)) = w;
                if (rmax) {
                    unsigned mb = 0u;
#pragma unroll
                    for (int e = 0; e < 4; ++e) { const unsigned x = w[e]; const unsigned lo = (x << 16) & 0x7fff0000u, hi2 = x & 0x7fff0000u; mb = mb > lo ? mb : lo; mb = mb > hi2 ? mb : hi2; }
                    unsigned o1 = __shfl_xor(mb, 16); mb = mb > o1 ? mb : o1; o1 = __shfl_xor(mb, 32); mb = mb > o1 ? mb : o1;
                    if (fq == 0) atomicMax(rmax + row, mb);
                }
            }
    }
};
struct EpiResidQ {
    static constexpr bool PERM = true; typedef i32x4 acc_t;
    const float* res; float* out; u64* racc; const float* sh; const float* sbn; float alpha; bf16_t* ob;
    __device__ __forceinline__ void operator()(const i32x4 (&acc)[2][2][4][2], const pg8::Unit& u, int wr, int wc, int fr, int fq) const {
        int row0 = u.pm * 256 + wr * 64 + fr, col0 = u.pn * 256 + wc * 32 + 8 * fq;
        asm volatile("" : "+v"(row0), "+v"(col0));
        f32x4 s0[2], s1[2];
#pragma unroll
        for (int bj = 0; bj < 2; ++bj) { s0[bj] = *(const f32x4*)(sbn + col0 + bj * 128); s1[bj] = *(const f32x4*)(sbn + col0 + bj * 128 + 4); }
#pragma unroll
        for (int ai = 0; ai < 2; ++ai)
#pragma unroll
            for (int mh = 0; mh < 2; ++mh) {
                f32x4 pa[2][2], pb[2][2]; float rs[2];
#pragma unroll
                for (int mm = 0; mm < 2; ++mm) { const int row = row0 + ai * 128 + (2 * mh + mm) * 16; rs[mm] = sh[row] * alpha;
#pragma unroll
                    for (int bj = 0; bj < 2; ++bj) { const size_t off = (size_t)row * DM + col0 + bj * 128; pa[mm][bj] = *(const f32x4*)(res + off); pb[mm][bj] = *(const f32x4*)(res + off + 4); } }
#pragma unroll
                for (int mm = 0; mm < 2; ++mm) {
                    const int m = 2 * mh + mm, row = row0 + ai * 128 + m * 16; float ss = 0.f;
#pragma unroll
                    for (int bj = 0; bj < 2; ++bj) {
                        const size_t off = (size_t)row * DM + col0 + bj * 128; f32x4 v0, v1;
#pragma unroll
                        for (int e = 0; e < 4; ++e) { v0[e] = pa[mm][bj][e] + (float)acc[ai][bj][m][0][e] * rs[mm] * s0[bj][e]; v1[e] = pb[mm][bj][e] + (float)acc[ai][bj][m][1][e] * rs[mm] * s1[bj][e]; }
                        if (out) { *(f32x4*)(out + off) = v0; *(f32x4*)(out + off + 4) = v1; }
                        if (ob) { u32x4 w; w.x = cvt_pk_bf16(v0[0], v0[1]); w.y = cvt_pk_bf16(v0[2], v0[3]); w.z = cvt_pk_bf16(v1[0], v1[1]); w.w = cvt_pk_bf16(v1[2], v1[3]); *(u32x4*)(ob + blk_off(row, col0 + bj * 128, KT4)) = w; }
                        ss += (v0[0] * v0[0] + v0[1] * v0[1]) + (v0[2] * v0[2] + v0[3] * v0[3]) + (v1[0] * v1[0] + v1[1] * v1[1]) + (v1[2] * v1[2] + v1[3] * v1[3]);
                    }
                    ss += __shfl_xor(ss, 16); ss += __shfl_xor(ss, 32);
                    if (fq == 0 && racc) atomicAdd(racc + row, (u64)(ss * 4294967296.0f));
                }
            }
    }
};
struct EpiResid {
    static constexpr bool PERM = true; typedef f32x4 acc_t;
    const float* res; float* out; bf16_t* ob; u64* racc; float alpha;
    __device__ __forceinline__ void operator()(const f32x4 (&acc)[2][2][4][2], const pg8::Unit& u, int wr, int wc, int fr, int fq) const {
        const int row0 = u.pm * 256 + wr * 64 + fr, col0 = u.pn * 256 + wc * 32 + 8 * fq;
#pragma unroll
        for (int ai = 0; ai < 2; ++ai) {
            f32x4 pa[4][2], pb[4][2];
#pragma unroll
            for (int m = 0; m < 4; ++m)
#pragma unroll
                for (int bj = 0; bj < 2; ++bj) { const size_t off = (size_t)(row0 + ai * 128 + m * 16) * DM + col0 + bj * 128; pa[m][bj] = *(const f32x4*)(res + off); pb[m][bj] = *(const f32x4*)(res + off + 4); }
#pragma unroll
            for (int m = 0; m < 4; ++m) {
                const int row = row0 + ai * 128 + m * 16; float ss = 0.f;
#pragma unroll
                for (int bj = 0; bj < 2; ++bj) {
                    const size_t off = (size_t)row * DM + col0 + bj * 128;
                    const f32x4 v0 = pa[m][bj] + acc[ai][bj][m][0] * alpha, v1 = pb[m][bj] + acc[ai][bj][m][1] * alpha;
                    *(f32x4*)(out + off) = v0; *(f32x4*)(out + off + 4) = v1;
                    if (ob) { u32x4 w; w.x = cvt_pk_bf16(v0[0], v0[1]); w.y = cvt_pk_bf16(v0[2], v0[3]); w.z = cvt_pk_bf16(v1[0], v1[1]); w.w = cvt_pk_bf16(v1[2], v1[3]); *(u32x4*)(ob + blk_off(row, col0 + bj * 128, KT4)) = w; }
                    ss += (v0[0] * v0[0] + v0[1] * v0[1]) + (v0[2] * v0[2] + v0[3] * v0[3]) + (v1[0] * v1[0] + v1[1] * v1[1]) + (v1[2] * v1[2] + v1[3] * v1[3]);
                }
                ss += __shfl_xor(ss, 16); ss += __shfl_xor(ss, 32);
                if (fq == 0 && racc) atomicAdd(racc + row, (u64)(ss * 4294967296.0f));
            }
        }
    }
};
struct EpiWin {
    static constexpr bool PERM = true; typedef f32x4 acc_t;
    bf16_t* qb; bf16_t* kvb; float* ub; float* gb; const u64* racc; size_t kv_stride;
    __device__ __forceinline__ void operator()(const f32x4 (&acc)[2][2][4][2], const pg8::Unit& u, int wr, int wc, int fr, int fq) const {
        const int row0 = u.pm * 256 + wr * 64 + fr, pn = u.pn, cw = wc * 32 + 8 * fq;
        float rr[2][4];
#pragma unroll
        for (int ai = 0; ai < 2; ++ai)
#pragma unroll
            for (int m = 0; m < 4; ++m) rr[ai][m] = rs_from_acc(racc[row0 + ai * 128 + m * 16]);
#pragma unroll
        for (int ai = 0; ai < 2; ++ai)
#pragma unroll
            for (int m = 0; m < 4; ++m) {
                const int row = row0 + ai * 128 + m * 16, b = row >> 11, s = row & 2047;
                const float r = rr[ai][m];
#pragma unroll
                for (int bj = 0; bj < 2; ++bj) {
                    f32x4 v0 = acc[ai][bj][m][0] * r, v1 = acc[ai][bj][m][1] * r;
                    if (pn < 8) {
                        v0 = v0 * QSCALE; v1 = v1 * QSCALE; const int h = 2 * pn + bj;
                        u32x4 w; w.x = cvt_pk_bf16(v0[0], v0[1]); w.y = cvt_pk_bf16(v0[2], v0[3]); w.z = cvt_pk_bf16(v1[0], v1[1]); w.w = cvt_pk_bf16(v1[2], v1[3]);
                        *(u32x4*)(qb + ((size_t)(b * NH + h) * SEQ + s) * HD + cw) = w;
                    } else if (pn < 20) {
                        const int ti = (pn - 8) >> 1, gg = ((pn - 8) & 1) * 2 + bj;
                        u32x4 w; w.x = cvt_pk_bf16(v0[0], v0[1]); w.y = cvt_pk_bf16(v0[2], v0[3]); w.z = cvt_pk_bf16(v1[0], v1[1]); w.w = cvt_pk_bf16(v1[2], v1[3]);
                        *(u32x4*)(kvb + (size_t)ti * kv_stride + ((size_t)(b * NG + gg) * SEQ + s) * HD + cw) = w;
                    } else if (pn < 28) {
                        float* p = ub + (size_t)row * DPOOL + (pn - 20) * 256 + bj * 128 + cw;
                        *(f32x4*)p = v0; *(f32x4*)(p + 4) = v1;
                    } else {
                        if (bj == 0 && cw < 48) {
                            float* p = gb + (size_t)row * 48 + cw; f32x4 s0, s1;
#pragma unroll
                            for (int e = 0; e < 4; ++e) { s0[e] = __builtin_amdgcn_rcpf(1.0f + __builtin_amdgcn_exp2f(-v0[e] * LOG2E)); s1[e] = __builtin_amdgcn_rcpf(1.0f + __builtin_amdgcn_exp2f(-v1[e] * LOG2E)); }
                            *(f32x4*)p = s0; *(f32x4*)(p + 4) = s1;
                        }
                    }
                }
            }
    }
};
struct EpiPool {
    static constexpr bool PERM = true; typedef f32x4 acc_t;
    bf16_t* ymix; const float* pscale;
    __device__ __forceinline__ void operator()(const f32x4 (&acc)[2][2][4][2], const pg8::Unit& u, int wr, int wc, int fr, int fq) const {
        const int row0 = u.pm * 256 + wr * 64 + fr, colb = u.g * 512 + u.pn * 256 + wc * 32 + 8 * fq;
#pragma unroll
        for (int bj = 0; bj < 2; ++bj) {
            const int col = colb + bj * 128; const f32x4 s0 = *(const f32x4*)(pscale + col), s1 = *(const f32x4*)(pscale + col + 4);
#pragma unroll
            for (int ai = 0; ai < 2; ++ai)
#pragma unroll
                for (int m = 0; m < 4; ++m) {
                    const int row = row0 + ai * 128 + m * 16; const f32x4 v0 = acc[ai][bj][m][0] * s0, v1 = acc[ai][bj][m][1] * s1;
                    u32x4 w; w.x = cvt_pk_bf16(v0[0], v0[1]); w.y = cvt_pk_bf16(v0[2], v0[3]); w.z = cvt_pk_bf16(v1[0], v1[1]); w.w = cvt_pk_bf16(v1[2], v1[3]);
                    *(u32x4*)(ymix + blk_off(row, DATT + col, KT4)) = w;
                }
        }
    }
};

constexpr size_t MiB = 1u << 20;
constexpr size_t WS_CTL = 0, CTL_ZERO_BYTES = 2 * MiB;
constexpr size_t WS_WGU1 = 2 * MiB, WS_WD1 = WS_WGU1 + 172 * MiB, WS_WIN = WS_WD1 + 86 * MiB, WS_WOUT = WS_WIN + 58 * MiB;
constexpr size_t WS_WGU2 = WS_WOUT + 32 * MiB, WS_WD2 = WS_WGU2 + 172 * MiB, WS_SMALL = WS_WD2 + 86 * MiB;
constexpr size_t SM_WPOOL = 0, SM_WCK1 = 3 * MiB, SM_WCV1 = 4 * MiB, SM_WCK2 = 5 * MiB, SM_WCV2 = 5 * MiB + 65536, SM_PBP = 5 * MiB + 131072, SM_R0 = 5 * MiB + 131072 + 262144;
constexpr size_t WS_HID = WS_SMALL + 7 * MiB, WS_ACTB = WS_HID + 172 * MiB, WS_Q = WS_ACTB + 64 * MiB, WS_KV = WS_Q + 32 * MiB;
constexpr size_t KV_STRIDE_B = 8 * MiB + 65536;
constexpr size_t WS_KCMP = WS_KV + 6 * KV_STRIDE_B, WS_VCMP = WS_KCMP + 1 * MiB, WS_GATES = WS_VCMP + 1 * MiB, WS_U = WS_GATES + 2 * MiB;
constexpr size_t WS_DPOOL = WS_U + 64 * MiB, WS_YMIX = WS_DPOOL + 32 * MiB, WS_END = WS_YMIX + 64 * MiB;
constexpr size_t WS_XQ = WS_END, WS_END2 = WS_XQ + 32 * MiB;
constexpr size_t SM_SB1 = 6 * MiB, SM_SB2 = 6 * MiB + 131072, SM_RA0 = 6 * MiB + 262144, SM_RA2 = 6 * MiB + 327680;
constexpr size_t WS_HIDQ = WS_END2, WS_END3 = WS_HIDQ + 86 * MiB;
constexpr int ROT1 = 2, ROT2 = 2;
constexpr size_t SM_SB4 = 6 * MiB + 458752;
constexpr size_t SM_SB3 = 6 * MiB + 393216, SM_SH = 6 * MiB + 425984;
constexpr size_t CTL_PBSUM = 1024 * 1024;
constexpr size_t CTL_RMAX = 768 * 1024;
constexpr size_t CTL_CMAX = 512 * 1024;
constexpr int CW_BAR = 4096;
constexpr size_t CTL_RACC = 256 * 1024;
static_assert(22016ull * 4096 * 2 == 172 * MiB && 4096ull * 11008 * 2 == 86 * MiB && 7424ull * 4096 * 2 == 58 * MiB, "weight sizes");

constexpr int RING_BYTES = 131072, LDS_BYTES = 163840, CTRL_OFF = LDS_BYTES - 2048, MISC_OFF = CTRL_OFF + 320, PTR_OFF = CTRL_OFF + 1024;
#define INP(k) ((const float*)(const GAS float*)(uintptr_t)(*(const LAS u64*)(F.lds + PTR_OFF + 8 * (k))))

#define XB_TMO      128
#define XB_XCNT(j)  (256  + 64 * (j))
#define XB_XSUB(j)  (1280 + 64 * (j))
#define XB_XGEN(j)  (2304 + 64 * (j))
#define XB_TOP      3328
#define XB_TOPGEN   3392
#define XCD_BAR_WORDS 3456
#define XB_SPIN_CAP (1u << 18)
__device__ __forceinline__ unsigned xb_ld(unsigned* p)              { return __hip_atomic_load(p, __ATOMIC_RELAXED, __HIP_MEMORY_SCOPE_AGENT); }
__device__ __forceinline__ unsigned xb_add(unsigned* p, unsigned v) { return __hip_atomic_fetch_add(p, v, __ATOMIC_RELAXED, __HIP_MEMORY_SCOPE_AGENT); }
__device__ __forceinline__ unsigned xb_xcc_id() { return (unsigned)__builtin_amdgcn_s_getreg((3 << 11) | 20) & 0xFu; }
#define XB_SPIN(cond, bar) do { unsigned _sp = 0; while (cond) { __builtin_amdgcn_s_sleep(1); \
    if ((++_sp & 255u) == 0u) { if (xb_ld(&(bar)[XB_TMO])) break; if (_sp > XB_SPIN_CAP) { atomicAdd(&(bar)[XB_TMO], 1u); break; } } } } while (0)
struct XcdBarrier { unsigned* bar; unsigned x; volatile LAS unsigned* st; };
__device__ __forceinline__ XcdBarrier xcd_barrier_post(unsigned* bar, volatile LAS unsigned* st) {
    XcdBarrier b; b.bar = bar; b.x = xb_xcc_id(); b.st = st;
    if (threadIdx.x == 0) (void)xb_add(&bar[XB_XCNT(b.x)], 1u);
    return b;
}
__device__ __forceinline__ void xcd_barrier_complete(unsigned* bar, unsigned x, unsigned& nloc, unsigned& nx) {
    const unsigned G = gridDim.x * gridDim.y * gridDim.z;
    unsigned sum, cnt, mine, sp = 0u;
    for (;;) {
        sum = 0u; cnt = 0u; mine = 0u;
#pragma unroll
        for (unsigned j = 0; j < 16; ++j) { const unsigned c = xb_ld(&bar[XB_XCNT(j)]); sum += c; cnt += (c > 0u) ? 1u : 0u; mine = (j == x) ? c : mine; }
        if (sum == G) break;
        __builtin_amdgcn_s_sleep(1);
        if ((++sp & 255u) == 0u) { if (xb_ld(&bar[XB_TMO])) break; if (sp > XB_SPIN_CAP) { atomicAdd(&bar[XB_TMO], 1u); break; } }
    }
    nloc = mine > 0u ? mine : 1u; nx = cnt > 0u ? cnt : 1u;
}
__device__ __forceinline__ void xcd_barrier(const XcdBarrier& b) {
    asm volatile("s_waitcnt vmcnt(0)" ::: "memory");
    __syncthreads();
    if (threadIdx.x == 0) {
        unsigned* bar = b.bar;
        __builtin_amdgcn_s_waitcnt(0);
        unsigned nloc = b.st[0], nx = b.st[1];
        if (nloc == 0u) { xcd_barrier_complete(bar, b.x, nloc, nx); b.st[0] = nloc; b.st[1] = nx; }
        const unsigned old = xb_add(&bar[XB_XSUB(b.x)], 1u);
        const unsigned gen = old / nloc;
        if (old + 1u == (gen + 1u) * nloc) {
            __builtin_amdgcn_fence(__ATOMIC_RELEASE, "agent");
            asm volatile("s_waitcnt vmcnt(0)" ::: "memory");
            const unsigned og = xb_add(&bar[XB_TOP], 1u);
            const unsigned tg = og / nx;
            if (og + 1u == (tg + 1u) * nx) xb_add(&bar[XB_TOPGEN], 1u);
            else XB_SPIN(xb_ld(&bar[XB_TOPGEN]) == tg, bar);
            __builtin_amdgcn_fence(__ATOMIC_ACQUIRE, "agent");
            xb_add(&bar[XB_XGEN(b.x)], 1u);
            asm volatile("s_waitcnt vmcnt(0)" ::: "memory");
        } else {
            XB_SPIN(xb_ld(&bar[XB_XGEN(b.x)]) == gen, bar);
            __builtin_amdgcn_fence(__ATOMIC_ACQUIRE, "agent");
            asm volatile("s_waitcnt vmcnt(0)" ::: "memory");
        }
    }
    __syncthreads();
}

struct Frame {
    LAS unsigned char* lds;
    int tid, wave, vcu, G;
    float* out; unsigned char* ws;
};
__device__ __forceinline__ unsigned f2bf(float f) { unsigned u = __builtin_bit_cast(unsigned, f); return (u + 0x7fffu + ((u >> 16) & 1u)) >> 16; }
__device__ __forceinline__ unsigned pk2(float lo, float hi) { return f2bf(lo) | (f2bf(hi) << 16); }
__device__ __forceinline__ float wave_sum(float v) {
#pragma unroll
    for (int o = 1; o < 64; o <<= 1) v += __shfl_xor(v, o);
    return v;
}
#define LDS_WAIT() asm volatile("s_waitcnt lgkmcnt(0)" ::: "memory")

__device__ __forceinline__ int win_map(int n) { return n < 5120 ? n : (n < 5168 ? 7168 + (n - 5120) : 5120 + (n - 5168)); }
struct P0Desc { const float* W; const float* gain; bf16_t* WT; int K, N, ldt, mode, bj, k0, n0; };
__device__ __forceinline__ void p0_load(f32x4 (&v)[16], float& gv, const P0Desc& d, int lane) {
    const int n = d.n0 + 4 * (lane & 15); const bool ok = n < d.N;
    gv = d.gain ? d.gain[d.k0 + lane] : 1.0f;
    const float* __restrict__ src = d.W + (size_t)(d.k0 + 2 * (lane >> 4)) * d.N + (ok ? n : 0);
#pragma unroll
    for (int i = 0; i < 16; ++i) v[i] = __builtin_nontemporal_load((const f32x4*)(src + (size_t)(8 * (i >> 1) + (i & 1)) * d.N));
}
__device__ __forceinline__ void p0_finish(f32x4 (&v)[16], float gv, const P0Desc& d, LAS unsigned* T, int lane) {
    const int kr = lane >> 4, nq = lane & 15;
#pragma unroll
    for (int j = 0; j < 8; ++j) {
        f32x4 a = v[2 * j], b = v[2 * j + 1];
        if (d.gain) { const float g0 = __shfl(gv, 8 * j + 2 * kr), g1 = __shfl(gv, 8 * j + 2 * kr + 1); a = a * g0; b = b * g1; }
#pragma unroll
        for (int e = 0; e < 4; ++e) T[(4 * nq + e) * 33 + 4 * j + kr] = cvt_pk_bf16(a[e], b[e]);
    }
    LDS_WAIT(); asm volatile("" ::: "memory");
    const int nl = lane >> 3, c = lane & 7;
#pragma unroll
    for (int g = 0; g < 8; ++g) {
        const int nloc = 8 * g + nl, n = d.n0 + nloc;
        const LAS unsigned* t = T + nloc * 33 + 4 * c;
        u32x4 o; o.x = t[0]; o.y = t[1]; o.z = t[2]; o.w = t[3];
        const int dr = d.mode == 0 ? n : (d.mode == 1 ? win_map(n) : 256 * (n >> 7) + 128 * d.bj + (n & 127));
        if (n < d.N) *(u32x4*)(d.WT + (d.ldt ? (size_t)dr * d.ldt + d.k0 + 8 * c : blk_off(dr, d.k0 + 8 * c, d.K >> 6))) = o;
    }
    LDS_WAIT(); asm volatile("" ::: "memory");
}
constexpr int P0_I_GU = 64 * 172, P0_I_D = 172 * 64, P0_I_IN = 64 * 113, P0_I_OUT = 64 * 64, P0_I_POOL = 8 * 8, P0_I_C1 = 64 * 2, P0_I_C2 = 2 * 2;
constexpr int P0_NITEMS = 4 * P0_I_GU + 2 * P0_I_D + P0_I_IN + P0_I_OUT + 4 * P0_I_POOL + 2 * P0_I_C1 + 2 * P0_I_C2;
__device__ __forceinline__ void p0_decode(Frame& F, int it, P0Desc& d) {
    unsigned char* ws = F.ws; int r = it; d.gain = nullptr; d.mode = 0; d.bj = 0;
    if (r < 4 * P0_I_GU) { const int q = r / P0_I_GU; r -= q * P0_I_GU; d.k0 = 64 * (r / 172); d.n0 = 64 * (r % 172); d.K = DM; d.ldt = 0; d.N = FF; d.mode = 2; d.bj = q & 1;
        d.W = q == 0 ? INP(2) : q == 1 ? INP(3) : q == 2 ? INP(18) : INP(19); d.gain = q < 2 ? INP(1) : INP(17); d.WT = (bf16_t*)(ws + (q < 2 ? WS_WGU1 : WS_WGU2)); return; }
    r -= 4 * P0_I_GU;
    if (r < 2 * P0_I_D) { const int q = r / P0_I_D; r -= q * P0_I_D; d.k0 = 64 * (r / 64); d.n0 = 64 * (r % 64); d.K = FF; d.ldt = 0; d.N = DM; d.W = q == 0 ? INP(4) : INP(20); d.WT = (bf16_t*)(ws + (q == 0 ? WS_WD1 : WS_WD2)); return; }
    r -= 2 * P0_I_D;
    if (r < P0_I_IN) { d.k0 = 64 * (r / 113); d.n0 = 64 * (r % 113); d.K = DM; d.ldt = 0; d.N = NIN; d.mode = 1; d.W = INP(6); d.gain = INP(5); d.WT = (bf16_t*)(ws + WS_WIN); return; }
    r -= P0_I_IN;
    if (r < P0_I_OUT) { d.k0 = 64 * (r / 64); d.n0 = 64 * (r % 64); d.K = DM; d.ldt = 0; d.N = DM; d.W = INP(15); d.WT = (bf16_t*)(ws + WS_WOUT); return; }
    r -= P0_I_OUT;
    if (r < 4 * P0_I_POOL) { const int q = r / P0_I_POOL; r -= q * P0_I_POOL; d.k0 = 64 * (r / 8); d.n0 = 64 * (r % 8); d.K = 512; d.ldt = 0; d.N = 512; d.W = INP(13) + (size_t)q * 512 * 512; d.WT = (bf16_t*)(ws + WS_SMALL + SM_WPOOL) + (size_t)q * 512 * 512; return; }
    r -= 4 * P0_I_POOL;
    if (r < 2 * P0_I_C1) { const int q = r / P0_I_C1; r -= q * P0_I_C1; d.k0 = 64 * (r / 2); d.n0 = 64 * (r % 2); d.K = 4096; d.ldt = 4096; d.N = 128; d.W = q == 0 ? INP(8) : INP(11); d.WT = (bf16_t*)(ws + WS_SMALL + (q == 0 ? SM_WCK1 : SM_WCV1)); return; }
    r -= 2 * P0_I_C1;
    { const int q = r / P0_I_C2; r -= q * P0_I_C2; d.k0 = 64 * (r / 2); d.n0 = 64 * (r % 2); d.K = 128; d.ldt = 128; d.N = 128; d.W = q == 0 ? INP(9) : INP(12); d.WT = (bf16_t*)(ws + WS_SMALL + (q == 0 ? SM_WCK2 : SM_WCV2)); }
}

__device__ __forceinline__ void p0_convert(Frame& F, int lo, int hi, int worker, int nworkers) {
    const int lane = (F.tid & 63), stride = nworkers * 8, first = lo + worker * 8 + F.wave;
    LAS unsigned* T = (LAS unsigned*)(F.lds + F.wave * 16384);
    if (first >= hi) return;
    const int n_my = (hi - first + stride - 1) / stride;
    f32x4 va[16], vb[16]; float ga, gb; P0Desc da, db;
    p0_decode(F, first, da); p0_load(va, ga, da, lane);
    for (int i = 0; i < n_my; i += 2) {
        { const int j = i + 1 < n_my ? i + 1 : n_my - 1; p0_decode(F, first + j * stride, db); p0_load(vb, gb, db, lane); }
        p0_finish(va, ga, da, T, lane);
        { const int j = i + 2 < n_my ? i + 2 : n_my - 1; p0_decode(F, first + j * stride, da); p0_load(va, ga, da, lane); }
        if (i + 1 < n_my) p0_finish(vb, gb, db, T, lane);
    }
}
constexpr int P0_R_GU2 = 2 * P0_I_GU, P0_R_D1 = 4 * P0_I_GU, P0_R_D2 = P0_R_D1 + P0_I_D, P0_R_IN = P0_R_D2 + P0_I_D, P0_R_OUT = P0_R_IN + P0_I_IN, P0_R_SMALL = P0_R_OUT + P0_I_OUT;
__device__ __forceinline__ void p0_convert_simple(Frame& F, int lo, int hi, int worker, int nworkers) {
    const int lane = (F.tid & 63), stride = nworkers * 8;
    LAS unsigned* T = (LAS unsigned*)(F.lds + F.wave * 16384);
    for (int it = lo + worker * 8 + F.wave; it < hi; it += stride) { f32x4 va[16]; float ga; P0Desc da; p0_decode(F, it, da); p0_load(va, ga, da, lane); p0_finish(va, ga, da, T, lane); }
}
__device__ __forceinline__ void tail_convert(Frame& F, int nwg, int lo, int hi) {
    const int r = nwg % F.G, c = (int)blockIdx.x;
    if (r == 0) p0_convert(F, lo, hi, c, F.G);
    else if (c >= r) p0_convert_simple(F, lo, hi, c - r, F.G - r);
}

__device__ __forceinline__ int gu_dest(int n, int bj) { return 256 * (n >> 7) + 128 * bj + (n & 127); }
__device__ __forceinline__ int q8(float x) { x = __builtin_rintf(x); x = x > 127.f ? 127.f : (x < -127.f ? -127.f : x); return (int)x; }
__device__ __forceinline__ unsigned pack4_i8(float a, float b, float c, float d) {
    unsigned w = __builtin_amdgcn_cvt_pk_u8_f32(a + 128.0f, 0u, 0u); w = __builtin_amdgcn_cvt_pk_u8_f32(b + 128.0f, 1u, w); w = __builtin_amdgcn_cvt_pk_u8_f32(c + 128.0f, 2u, w); w = __builtin_amdgcn_cvt_pk_u8_f32(d + 128.0f, 3u, w);
    return w ^ 0x80808080u;
}
constexpr int GU_STRIPS = 5504, GU_STRIPS_ALL = 5504 + 22 * 64;
template <int ROT>
__device__ __forceinline__ void gu_absmax(Frame& F, int s_lo, int s_hi) {
    const int gw = F.vcu * 8 + F.wave, NGW = F.G * 8, lane = (F.tid & 63), kr = lane >> 4, nq = lane & 15;
    for (int sidx = s_lo + gw; sidx < s_hi; sidx += NGW) {
        int q, r; if (sidx < GU_STRIPS) { q = sidx / 1376; r = sidx % 1376; } else if (sidx < GU_STRIPS_ALL) { q = 4; r = sidx - GU_STRIPS; } else { q = 5; r = sidx - GU_STRIPS_ALL; }
        const int nbk = q < 4 ? 172 : 64, kb = r / nbk, nb = r % nbk, rowlen = q < 4 ? FF : DM, ktot = q < 4 ? DM : FF;
        const float* W = q == 0 ? INP(2) : q == 1 ? INP(3) : q == 2 ? INP(18) : q == 3 ? INP(19) : q == 4 ? INP(20) : INP(4); const float* gain = q < 2 ? INP(1) : (q < 4 ? INP(17) : nullptr);
        unsigned* cmax = (unsigned*)(F.ws + WS_CTL + CTL_CMAX) + (q < 4 ? (q >> 1) * NGU : 2 * NGU + (q - 4) * DM);
        const int n = 64 * nb + 4 * nq;
        const float* src = W + (size_t)(512 * kb + 2 * kr) * rowlen + n;
        int ntl = (ktot - 512 * kb) / 64; ntl = ntl > 8 ? 8 : ntl;
        f32x4 cm = (f32x4){0.f, 0.f, 0.f, 0.f};
#pragma unroll 2
        for (int t = 0; t < ntl; ++t) {
            const float gv = gain ? gain[512 * kb + 64 * t + lane] : 1.0f;
            f32x4 v[16];
#pragma unroll
            for (int i = 0; i < 16; ++i) v[i] = *(const f32x4*)(src + (size_t)(64 * t + 8 * (i >> 1) + (i & 1)) * rowlen);
            if (ROT) {
#pragma unroll
                for (int st = 1; st <= (ROT <= 3 ? 1 : ROT == 4 ? 2 : 4); st <<= 1)
#pragma unroll
                    for (int i = 0; i < 16; ++i) if (!(i & st)) { const f32x4 a = v[i], b = v[i | st]; v[i] = a + b; v[i | st] = a - b; }
                { const bool s16 = (lane & 16) != 0, s32 = (lane & 32) != 0;
#pragma unroll
                  for (int i = 0; i < 16; ++i)
#pragma unroll
                      for (int e = 0; e < 4; ++e) { float x = v[i][e]; if (ROT >= 2) x = bfly16(x, s16); if (ROT >= 3) x = bfly32(x, s32); v[i][e] = x; } }
#pragma unroll
                for (int i = 0; i < 16; ++i) v[i] *= (ROT == 1 ? 0.70710678118654752f : ROT == 2 ? 0.5f : ROT == 3 ? 0.35355339059327373f : ROT == 4 ? 0.25f : 0.17677669529663687f);
            }
#pragma unroll
            for (int i = 0; i < 16; ++i) { const float g = __shfl(gv, 8 * (i >> 1) + 2 * kr + (i & 1)); const f32x4 a = __builtin_elementwise_abs(v[i] * g); cm = __builtin_elementwise_max(cm, a); }
        }
#pragma unroll
        for (int e = 0; e < 4; ++e) { float c = cm[e]; c = fmaxf(c, __shfl_xor(c, 16)); c = fmaxf(c, __shfl_xor(c, 32)); cm[e] = c; }
        if (kr == 0) {
            const int d0 = q < 4 ? gu_dest(n, q & 1) : n;
#pragma unroll
            for (int e = 0; e < 4; ++e) atomicMax(cmax + d0 + e, __float_as_uint(cm[e]));
        }
    }
}
struct GUDesc { const float* W; const float* gain; unsigned char* WQ; const unsigned* cmax; float* sb; int bj, k0, n0, N, kt8, il; };
constexpr int Q_R_D1Q = 5 * P0_I_GU;
constexpr int Q_R_D2 = 4 * P0_I_GU;
__device__ __forceinline__ void gu_decode(Frame& F, int it, GUDesc& d) {
    const int q = it / P0_I_GU, r = it % P0_I_GU;
    if (q < 4) { d.k0 = 128 * (r / 344); d.n0 = 32 * (r % 344); d.bj = q & 1; d.N = FF; d.kt8 = KT8; d.il = 1;
        d.W = q == 0 ? INP(2) : q == 1 ? INP(3) : q == 2 ? INP(18) : INP(19); d.gain = q < 2 ? INP(1) : INP(17);
        d.WQ = F.ws + (q < 2 ? WS_WGU1 : WS_WGU2); d.cmax = (const unsigned*)(F.ws + WS_CTL + CTL_CMAX) + (q >> 1) * NGU; d.sb = (float*)(F.ws + WS_SMALL + (q < 2 ? SM_SB1 : SM_SB2)); }
    else { d.k0 = 128 * (r / 128); d.n0 = 32 * (r % 128); d.bj = 0; d.N = DM; d.kt8 = FF / 128; d.il = 0; d.W = q == 4 ? INP(20) : INP(4); d.gain = nullptr;
        d.WQ = F.ws + (q == 4 ? WS_WD2 : WS_WD1); d.cmax = (const unsigned*)(F.ws + WS_CTL + CTL_CMAX) + 2 * NGU + (q == 4 ? 0 : DM); d.sb = (float*)(F.ws + WS_SMALL + (q == 4 ? SM_SB3 : SM_SB4)); }
}
__device__ __forceinline__ void gu_load(f32x4 (&v)[16], float& gA, float& gB, const GUDesc& d, int lane) {
    const int kr = lane >> 3, nq = lane & 7;
    const float* __restrict__ src = d.W + (size_t)(d.k0 + 4 * kr) * d.N + d.n0 + 4 * nq;
    gA = d.gain ? d.gain[d.k0 + lane] : 1.0f; gB = d.gain ? d.gain[d.k0 + 64 + lane] : 1.0f;
#pragma unroll
    for (int i = 0; i < 16; ++i) v[i] = *(const f32x4*)(src + (size_t)(32 * (i >> 2) + (i & 3)) * d.N);
}
template <int ROT>
__device__ __forceinline__ void rot32_tile(f32x4 (&v)[16], int lane) {
#pragma unroll
    for (int jq = 0; jq < 4; ++jq) {
        const f32x4 a = v[4 * jq], b = v[4 * jq + 1], c = v[4 * jq + 2], d = v[4 * jq + 3];
        const f32x4 a1 = a + b, b1 = a - b, c1 = c + d, d1 = c - d;
        if (ROT >= 2) { v[4 * jq] = a1 + c1; v[4 * jq + 2] = a1 - c1; v[4 * jq + 1] = b1 + d1; v[4 * jq + 3] = b1 - d1; }
        else { v[4 * jq] = a1; v[4 * jq + 1] = b1; v[4 * jq + 2] = c1; v[4 * jq + 3] = d1; }
    }
    { const bool s8 = (lane & 8) != 0, s16 = (lane & 16) != 0, s32 = (lane & 32) != 0;
#pragma unroll
      for (int i = 0; i < 16; ++i)
#pragma unroll
          for (int e = 0; e < 4; ++e) { float x = v[i][e]; if (ROT >= 3) x = bfly8(x, s8); if (ROT >= 4) x = bfly16(x, s16); if (ROT >= 5) x = bfly32(x, s32); v[i][e] = x; } }
#pragma unroll
    for (int i = 0; i < 16; ++i) v[i] *= (ROT == 1 ? 0.70710678118654752f : ROT == 2 ? 0.5f : ROT == 3 ? 0.35355339059327373f : ROT == 4 ? 0.25f : 0.17677669529663687f);
}
template <bool STRIP, int ROT>
__device__ __forceinline__ void gu_finish_t(f32x4 (&v)[16], float gA, float gB, const GUDesc& d, LAS unsigned* T, int lane, const float (&sinv)[4]) {
    const int kr = lane >> 3, nq = lane & 7;
    const int dq0 = d.il ? gu_dest(d.n0 + 4 * nq, d.bj) : d.n0 + 4 * nq;
    if (ROT) rot32_tile<ROT>(v, lane);
    float inv[4];
#pragma unroll
    for (int e = 0; e < 4; ++e) { if (STRIP) inv[e] = sinv[e]; else { const float cm = __uint_as_float(d.cmax[dq0 + e]); inv[e] = cm > 0.f ? 127.0f / cm : 0.f; } }
#pragma unroll
    for (int jq = 0; jq < 4; ++jq) {
        float g[4];
#pragma unroll
        for (int e2 = 0; e2 < 4; ++e2) g[e2] = jq < 2 ? __shfl(gA, 32 * jq + 4 * kr + e2) : __shfl(gB, 32 * (jq - 2) + 4 * kr + e2);
#pragma unroll
        for (int e = 0; e < 4; ++e)
            T[(4 * nq + e) * 33 + 8 * jq + kr] = pack4_i8(v[4 * jq + 0][e] * g[0] * inv[e], v[4 * jq + 1][e] * g[1] * inv[e], v[4 * jq + 2][e] * g[2] * inv[e], v[4 * jq + 3][e] * g[3] * inv[e]);
    }
    LDS_WAIT(); asm volatile("" ::: "memory");
    const int nl = lane >> 3, c = lane & 7;
#pragma unroll
    for (int g4 = 0; g4 < 4; ++g4) {
        const int nloc = 8 * g4 + nl, dr = d.il ? gu_dest(d.n0 + nloc, d.bj) : d.n0 + nloc;
        const LAS unsigned* t = T + nloc * 33 + 4 * c;
        u32x4 o; o.x = t[0]; o.y = t[1]; o.z = t[2]; o.w = t[3];
        *(u32x4*)(d.WQ + blk8_off(dr, d.k0 + 16 * c, d.kt8)) = o;
        if (!STRIP) if (d.k0 == 0 && c == 0) d.sb[dr] = __uint_as_float(d.cmax[dr]) * (1.0f / 127.0f);
    }
    LDS_WAIT(); asm volatile("" ::: "memory");
}
template <int ROT>
__device__ __forceinline__ void gu_finish(f32x4 (&v)[16], float gA, float gB, const GUDesc& d, LAS unsigned* T, int lane) {
    const float z[4] = {0.f, 0.f, 0.f, 0.f}; gu_finish_t<false, ROT>(v, gA, gB, d, T, lane, z);
}
constexpr int GU_UNITS_GU = 4 * 344, GU_UNITS_ALL = GU_UNITS_GU + 128;
__device__ __forceinline__ void gu_strip(Frame& F, int uidx, int par) {
    const int lane = (F.tid & 63), kr = lane >> 3, nq = lane & 7;
    const int q = uidx < GU_UNITS_GU ? uidx / 344 : 4, nb = uidx < GU_UNITS_GU ? uidx % 344 : uidx - GU_UNITS_GU;
    const int nkt = q < 4 ? 32 : 86, it0 = q * P0_I_GU + nb, its = q < 4 ? 344 : 128;
    LAS unsigned* T = (LAS unsigned*)(F.lds + F.wave * 16384);
    LAS float* part = (LAS float*)(F.lds + 131072 + 1024 * (par & 1));
    GUDesc d; gu_decode(F, it0, d);
    f32x4 cm = {0.f, 0.f, 0.f, 0.f};
    for (int kt = F.wave; kt < nkt; kt += 8) {
        f32x4 v[16]; float gA, gB; d.k0 = 128 * kt; gu_load(v, gA, gB, d, lane);
#pragma unroll
        for (int jq = 0; jq < 4; ++jq) {
#pragma unroll
            for (int e2 = 0; e2 < 4; ++e2) {
                const float g = jq < 2 ? __shfl(gA, 32 * jq + 4 * kr + e2) : __shfl(gB, 32 * (jq - 2) + 4 * kr + e2);
#pragma unroll
                for (int e = 0; e < 4; ++e) cm[e] = fmaxf(cm[e], fabsf(v[4 * jq + e2][e] * g));
            }
        }
    }
#pragma unroll
    for (int e = 0; e < 4; ++e) { float m = cm[e]; m = fmaxf(m, __shfl_xor(m, 8)); m = fmaxf(m, __shfl_xor(m, 16)); m = fmaxf(m, __shfl_xor(m, 32)); cm[e] = m; }
    if (kr == 0) { for (int e = 0; e < 4; ++e) part[F.wave * 32 + 4 * nq + e] = cm[e]; }
    __syncthreads();
    float inv[4];
#pragma unroll
    for (int e = 0; e < 4; ++e) {
        float m = 0.f;
#pragma unroll
        for (int w = 0; w < 8; ++w) m = fmaxf(m, part[w * 32 + 4 * nq + e]);
        inv[e] = m > 0.f ? 127.0f / m : 0.f;
        if (F.wave == 0 && kr == 0) { const int n = d.n0 + 4 * nq + e; d.sb[d.il ? gu_dest(n, d.bj) : n] = m * (1.0f / 127.0f); }
    }
    for (int kt = F.wave; kt < nkt; kt += 8) {
        f32x4 v[16]; float gA, gB; d.k0 = 128 * kt; gu_load(v, gA, gB, d, lane);
        gu_finish_t<true, 0>(v, gA, gB, d, T, lane, inv);
    }
    (void)its;
}
__device__ __forceinline__ void gu_strips(Frame& F, int lo, int hi, int worker, int nworkers) {
    int par = 0;
    for (int u = lo + worker; u < hi; u += nworkers, ++par) gu_strip(F, u, par);
}
__device__ __forceinline__ void tail_strips(Frame& F, int nwg, int lo, int hi) {
    const int r = nwg % F.G, c = (int)blockIdx.x;
    if (r == 0) gu_strips(F, lo, hi, c, F.G);
    else if (c >= r) gu_strips(F, lo, hi, c - r, F.G - r);
}
template <int ROT = 0>
__device__ __forceinline__ void gu_quant(Frame& F, int lo, int hi, int worker, int nworkers) {
    const int lane = (F.tid & 63), stride = nworkers * 8, first = lo + worker * 8 + F.wave;
    LAS unsigned* T = (LAS unsigned*)(F.lds + F.wave * 16384);
    if (first >= hi) return;
    const int n_my = (hi - first + stride - 1) / stride;
    f32x4 va[16], vb[16]; float gaA, gaB, gbA, gbB; GUDesc da, db;
    gu_decode(F, first, da); gu_load(va, gaA, gaB, da, lane);
    for (int i = 0; i < n_my; i += 2) {
        { const int j = i + 1 < n_my ? i + 1 : n_my - 1; gu_decode(F, first + j * stride, db); gu_load(vb, gbA, gbB, db, lane); }
        gu_finish<ROT>(va, gaA, gaB, da, T, lane);
        { const int j = i + 2 < n_my ? i + 2 : n_my - 1; gu_decode(F, first + j * stride, da); gu_load(va, gaA, gaB, da, lane); }
        if (i + 1 < n_my) gu_finish<ROT>(vb, gbA, gbB, db, T, lane);
    }
}
template <int ROT = 0>
__device__ __forceinline__ void gu_quant_simple(Frame& F, int lo, int hi, int worker, int nworkers) {
    const int lane = (F.tid & 63), stride = nworkers * 8;
    LAS unsigned* T = (LAS unsigned*)(F.lds + F.wave * 16384);
    for (int it = lo + worker * 8 + F.wave; it < hi; it += stride) { f32x4 va[16]; float gA, gB; GUDesc da; gu_decode(F, it, da); gu_load(va, gA, gB, da, lane); gu_finish<ROT>(va, gA, gB, da, T, lane); }
}
template <int ROT = 0>
__device__ __forceinline__ void tail_quant(Frame& F, int nwg, int lo, int hi) {
    const int r = nwg % F.G, c = (int)blockIdx.x;
    if (r == 0) gu_quant<ROT>(F, lo, hi, c, F.G);
    else if (c >= r) gu_quant_simple<ROT>(F, lo, hi, c - r, F.G - r);
}
__device__ __forceinline__ void quant_rows(Frame& F, const float* x, unsigned char* xq, float* ra) {
    const int gw = F.vcu * 8 + F.wave, NGW = F.G * 8, lane = (F.tid & 63);
    for (int m = gw; m < M; m += NGW) {
        const f32x4* xr = (const f32x4*)(x + (size_t)m * DM) + lane;
        f32x4 v[16]; float s = 0.f, am = 0.f;
#pragma unroll
        for (int j = 0; j < 16; ++j) { v[j] = xr[64 * j]; s += (v[j].x * v[j].x + v[j].y * v[j].y) + (v[j].z * v[j].z + v[j].w * v[j].w);
            am = fmaxf(fmaxf(am, fmaxf(__builtin_fabsf(v[j].x), __builtin_fabsf(v[j].y))), fmaxf(__builtin_fabsf(v[j].z), __builtin_fabsf(v[j].w))); }
        s = wave_sum(s);
#pragma unroll
        for (int o = 1; o < 64; o <<= 1) am = fmaxf(am, __shfl_xor(am, o));
        const float inv = am > 0.f ? 127.0f / am : 0.f;
#pragma unroll
        for (int j = 0; j < 16; ++j) *(unsigned*)(xq + blk8_off(m, 4 * lane + 256 * j, KT8)) = pack4_i8(v[j].x * inv, v[j].y * inv, v[j].z * inv, v[j].w * inv);
        if (lane == 0) ra[m] = __builtin_amdgcn_rsqf(s * (1.0f / DM) + EPS) * am * (1.0f / 127.0f);
    }
}

__device__ __forceinline__ float bflyq1(float x, bool up) { const float p = __uint_as_float(__builtin_amdgcn_update_dpp(0u, __float_as_uint(x), 0xB1, 0xf, 0xf, false)); return up ? p - x : x + p; }
__device__ __forceinline__ float bflyq2(float x, bool up) { const float p = __uint_as_float(__builtin_amdgcn_update_dpp(0u, __float_as_uint(x), 0x4E, 0xf, 0xf, false)); return up ? p - x : x + p; }
__device__ __forceinline__ void qh_load(u32x4 (&v)[22], const bf16_t* hidp, int unit, int rl, int c, int kt0, int nk) {
    const bf16_t* src = hidp + blk_off(unit * 8 + rl, 64 * kt0, KTF) + 8 * c;
#pragma unroll
    for (int t = 0; t < 22; ++t) { const int tt = t < nk ? t : nk - 1; v[t] = *(const u32x4*)(src + (size_t)tt * (256 * 64)); }
}
template <int ROT>
__device__ __forceinline__ void qh_process(Frame& F, u32x4 (&v)[22], unsigned char* hq, float* sh, int unit, int par, int rl, int c, int kt0, int nk, const bf16_t* hidp, int next_unit) {
    LAS unsigned* part = (LAS unsigned*)(F.lds + 131072);
    const int wave = F.wave, row = unit * 8 + rl;
    const bool u1 = (c & 1) != 0, u2 = (c & 2) != 0;
    unsigned mb = 0u;
#pragma unroll
    for (int t = 0; t < 22; ++t) {
        float f0 = __uint_as_float(v[t].x << 16), f1 = __uint_as_float(v[t].x & 0xffff0000u), f2 = __uint_as_float(v[t].y << 16), f3 = __uint_as_float(v[t].y & 0xffff0000u);
        float f4 = __uint_as_float(v[t].z << 16), f5 = __uint_as_float(v[t].z & 0xffff0000u), f6 = __uint_as_float(v[t].w << 16), f7 = __uint_as_float(v[t].w & 0xffff0000u);
        u32x4 w = v[t];
        if (ROT) {
#define FW_BF(a, b) { const float t_ = a; a = t_ + b; b = t_ - b; }
            FW_BF(f0, f1) FW_BF(f2, f3) FW_BF(f4, f5) FW_BF(f6, f7)
            if (ROT >= 2) { FW_BF(f0, f2) FW_BF(f1, f3) FW_BF(f4, f6) FW_BF(f5, f7) }
            if (ROT >= 3) { FW_BF(f0, f4) FW_BF(f1, f5) FW_BF(f2, f6) FW_BF(f3, f7) }
#undef FW_BF
            const float sc = (ROT == 1 ? 0.70710678118654752f : ROT == 2 ? 0.5f : ROT == 3 ? 0.35355339059327373f : ROT == 4 ? 0.25f : 0.17677669529663687f);
#define FW_Q(f) { if (ROT >= 4) f = bflyq1(f, u1); if (ROT >= 5) f = bflyq2(f, u2); f *= sc; }
            FW_Q(f0) FW_Q(f1) FW_Q(f2) FW_Q(f3) FW_Q(f4) FW_Q(f5) FW_Q(f6) FW_Q(f7)
#undef FW_Q
            w.x = cvt_pk_bf16(f0, f1); w.y = cvt_pk_bf16(f2, f3); w.z = cvt_pk_bf16(f4, f5); w.w = cvt_pk_bf16(f6, f7);
            v[t] = w;
        }
#pragma unroll
        for (int e = 0; e < 4; ++e) { const unsigned x = w[e]; const unsigned lo = (x << 16) & 0x7fff0000u, hi2 = x & 0x7fff0000u; mb = mb > lo ? mb : lo; mb = mb > hi2 ? mb : hi2; }
    }
    { unsigned o1 = __shfl_xor(mb, 1); mb = mb > o1 ? mb : o1; o1 = __shfl_xor(mb, 2); mb = mb > o1 ? mb : o1; o1 = __shfl_xor(mb, 4); mb = mb > o1 ? mb : o1; }
    if (c == 0) part[(par * 8 + wave) * 8 + rl] = mb;
    __syncthreads();
    mb = 0u;
#pragma unroll
    for (int w8 = 0; w8 < 8; ++w8) { const unsigned o1 = part[(par * 8 + w8) * 8 + rl]; mb = mb > o1 ? mb : o1; }
    const float am = __uint_as_float(mb), inv = am > 0.f ? 127.0f / am : 0.f;
    if (wave == 0 && c == 0) sh[row] = am * (1.0f / 127.0f);
#pragma unroll
    for (int t = 0; t < 22; ++t) if (t < nk) {
        typedef unsigned u32x2_t __attribute__((ext_vector_type(2)));
        u32x2_t o;
        o.x = pack4_i8(__uint_as_float(v[t].x << 16) * inv, __uint_as_float(v[t].x & 0xffff0000u) * inv, __uint_as_float(v[t].y << 16) * inv, __uint_as_float(v[t].y & 0xffff0000u) * inv);
        o.y = pack4_i8(__uint_as_float(v[t].z << 16) * inv, __uint_as_float(v[t].z & 0xffff0000u) * inv, __uint_as_float(v[t].w << 16) * inv, __uint_as_float(v[t].w & 0xffff0000u) * inv);
        *(u32x2_t*)(hq + blk8_off(row, 64 * (kt0 + t) + 8 * c, FF / 128)) = o;
    }
    if (next_unit >= 0) qh_load(v, hidp, next_unit, rl, c, kt0, nk);
}
template <int ROT>
__device__ __forceinline__ void quant_hid_rot(Frame& F, const bf16_t* hidp, unsigned char* hq, float* sh) {
    typedef float f32x2_t __attribute__((ext_vector_type(2)));
    const int lane = (F.tid & 63), kq = lane >> 3, c = lane & 7;
    const int gw = F.vcu * 8 + F.wave, NGW = F.G * 8;
    const bool u1 = (c & 1) != 0, u2 = (c & 2) != 0, lastok = kq < 4;
    for (int row = gw; row < M; row += NGW) {
        const bf16_t* src = hidp + blk_off(row, 64 * kq, KTF) + 8 * c;
        u32x4 v[22];
#pragma unroll
        for (int j = 0; j < 22; ++j) v[j] = *(const u32x4*)(src + (size_t)((j < 21 || lastok) ? 8 * j : 0) * (256 * 64));
        float am = 0.f;
#pragma unroll
        for (int j = 0; j < 22; ++j) {
            f32x2_t A0 = {__uint_as_float(v[j].x << 16), __uint_as_float(v[j].z << 16)}, A1 = {__uint_as_float(v[j].x & 0xffff0000u), __uint_as_float(v[j].z & 0xffff0000u)};
            f32x2_t A2 = {__uint_as_float(v[j].y << 16), __uint_as_float(v[j].w << 16)}, A3 = {__uint_as_float(v[j].y & 0xffff0000u), __uint_as_float(v[j].w & 0xffff0000u)};
            if (ROT) {
#define FW_BF2(a, b) { const f32x2_t t_ = a; a = t_ + b; b = t_ - b; }
                FW_BF2(A0, A1) FW_BF2(A2, A3)
                if (ROT >= 2) { FW_BF2(A0, A2) FW_BF2(A1, A3) }
#undef FW_BF2
                if (ROT >= 3) {
                    A0 = (f32x2_t){A0.x + A0.y, A0.x - A0.y}; A1 = (f32x2_t){A1.x + A1.y, A1.x - A1.y}; A2 = (f32x2_t){A2.x + A2.y, A2.x - A2.y}; A3 = (f32x2_t){A3.x + A3.y, A3.x - A3.y}; }
#define FW_Q2(A) { if (ROT >= 4) { A.x = bflyq1(A.x, u1); A.y = bflyq1(A.y, u1); } if (ROT >= 5) { A.x = bflyq2(A.x, u2); A.y = bflyq2(A.y, u2); } }
                FW_Q2(A0) FW_Q2(A1) FW_Q2(A2) FW_Q2(A3)
#undef FW_Q2
                const float sc = (ROT == 1 ? 0.70710678118654752f : ROT == 2 ? 0.5f : ROT == 3 ? 0.35355339059327373f : ROT == 4 ? 0.25f : 0.17677669529663687f);
                const f32x2_t sc2 = {sc, sc};
                A0 = A0 * sc2; A1 = A1 * sc2; A2 = A2 * sc2; A3 = A3 * sc2;
                u32x4 w; w.x = cvt_pk_bf16(A0.x, A1.x); w.y = cvt_pk_bf16(A2.x, A3.x); w.z = cvt_pk_bf16(A0.y, A1.y); w.w = cvt_pk_bf16(A2.y, A3.y);
                v[j] = w;
            }
            am = fmaxf(fmaxf(am, fmaxf(__builtin_fabsf(A0.x), __builtin_fabsf(A1.x))), fmaxf(__builtin_fabsf(A2.x), __builtin_fabsf(A3.x)));
            am = fmaxf(fmaxf(am, fmaxf(__builtin_fabsf(A0.y), __builtin_fabsf(A1.y))), fmaxf(__builtin_fabsf(A2.y), __builtin_fabsf(A3.y)));
        }
#pragma unroll
        for (int o = 1; o < 64; o <<= 1) am = fmaxf(am, __shfl_xor(am, o));
        am *= 1.00390625f;
        const float inv = am > 0.f ? 127.0f / am : 0.f;
        if (lane == 0) sh[row] = am * (1.0f / 127.0f);
        const f32x2_t inv2 = {inv, inv}, c128 = {128.0f, 128.0f};
#pragma unroll
        for (int j = 0; j < 22; ++j) if (j < 21 || lastok) {
            typedef unsigned u32x2_t __attribute__((ext_vector_type(2)));
            u32x2_t o;
#define QH_Q4(wa, wb) ({ const f32x2_t p_ = (f32x2_t){__uint_as_float((wa) << 16), __uint_as_float((wa) & 0xffff0000u)} * inv2 + c128, q_ = (f32x2_t){__uint_as_float((wb) << 16), __uint_as_float((wb) & 0xffff0000u)} * inv2 + c128; \
            unsigned r_ = __builtin_amdgcn_cvt_pk_u8_f32(p_.x, 0u, 0u); r_ = __builtin_amdgcn_cvt_pk_u8_f32(p_.y, 1u, r_); r_ = __builtin_amdgcn_cvt_pk_u8_f32(q_.x, 2u, r_); r_ = __builtin_amdgcn_cvt_pk_u8_f32(q_.y, 3u, r_); r_ ^ 0x80808080u; })
            o.x = QH_Q4(v[j].x, v[j].y); o.y = QH_Q4(v[j].z, v[j].w);
#undef QH_Q4
            *(u32x2_t*)(hq + blk8_off(row, 64 * (8 * j + kq) + 8 * c, FF / 128)) = o;
        }
    }
}
__device__ __forceinline__ void quant_hid(Frame& F) {
    const int gw = F.vcu * 8 + F.wave, NGW = F.G * 8, lane = (F.tid & 63), rloc = lane >> 3, c = lane & 7;
    const bf16_t* hidp = (const bf16_t*)(F.ws + WS_HID); unsigned char* hq = F.ws + WS_HIDQ;
    const unsigned* rmax = (const unsigned*)(F.ws + WS_CTL + CTL_RMAX); float* sh = (float*)(F.ws + WS_SMALL + SM_SH);
    for (int it = gw; it < 32 * 86 * 2; it += NGW) {
        const int half = it & 1, kt8 = (it >> 1) % 86, pm = (it >> 1) / 86;
        const bf16_t* src = hidp + ((size_t)(pm * KTF + 2 * kt8 + (c >> 2)) * 256) * 64 + 16 * (c & 3);
        unsigned char* dst = hq + ((size_t)(pm * 86 + kt8) * 256) * 128 + 16 * c;
#pragma unroll 4
        for (int i = 0; i < 16; ++i) {
            const int rl = 128 * half + 8 * i + rloc, row = 256 * pm + rl;
            const float am = __uint_as_float(rmax[row]); const float inv = am > 0.f ? 127.0f / am : 0.f;
            const u32x4 a = *(const u32x4*)(src + (size_t)rl * 64), b = *(const u32x4*)(src + (size_t)rl * 64 + 8);
            u32x4 o;
#define Q2(x, y) pack4_i8(__uint_as_float((x) << 16) * inv, __uint_as_float((x) & 0xffff0000u) * inv, __uint_as_float((y) << 16) * inv, __uint_as_float((y) & 0xffff0000u) * inv)
            o.x = Q2(a.x, a.y); o.y = Q2(a.z, a.w); o.z = Q2(b.x, b.y); o.w = Q2(b.z, b.w);
#undef Q2
            *(u32x4*)(dst + (size_t)rl * 128) = o;
            if (kt8 == 0 && c == 0) sh[row] = am * (1.0f / 127.0f);
        }
    }
}

__device__ __forceinline__ void p0_prologue(Frame& F) {
    const int gw = F.vcu * 8 + F.wave, NGW = F.G * 8, lane = (F.tid & 63);
    unsigned char* ws = F.ws;
    p0_convert(F, P0_R_IN, P0_R_OUT, F.vcu, F.G);
    gu_quant<ROT1>(F, Q_R_D1Q, Q_R_D1Q + 5408, F.vcu, F.G);
    gu_quant<ROT2>(F, Q_R_D2, Q_R_D2 + 1708, F.vcu, F.G);
    p0_convert(F, P0_R_SMALL, P0_NITEMS, F.vcu, F.G);
    quant_rows(F, INP(0), F.ws + WS_XQ, (float*)(F.ws + WS_SMALL + SM_RA0));
    for (int t = gw; t < 256; t += NGW) {
        const int kv = t >> 7, ch = t & 127; const float* pos = (kv ? INP(10) : INP(7)) + ch * 32; const float* W1 = (kv ? INP(11) : INP(8)) + (size_t)ch * 32 * 128;
        float a0 = 0.f, a1 = 0.f;
#pragma unroll 8
        for (int k = 0; k < 32; ++k) { const float p = pos[k]; a0 += p * W1[k * 128 + lane]; a1 += p * W1[k * 128 + 64 + lane]; }
        float* pb = (float*)(ws + WS_SMALL + SM_PBP) + (size_t)t * 128; pb[lane] = a0; pb[64 + lane] = a1;
    }
    gu_strips(F, 0, 688, F.vcu, F.G);
    if (gw < 6) { u32x4* p = (u32x4*)(ws + WS_KV + (size_t)gw * KV_STRIDE_B + 8 * MiB); for (int i = lane; i < 4096; i += 64) p[i] = (u32x4){0u, 0u, 0u, 0u}; }
}

__device__ __forceinline__ void compress_unit(Frame& F, int kv, int rt) {
    const int tid = F.tid, lane = (F.tid & 63), wid = F.wave, r32 = lane & 31, hi = lane >> 5;
    unsigned char* ws = F.ws;
    const bf16_t* Af = (const bf16_t*)(ws + WS_KV + (size_t)kv * KV_STRIDE_B);
    const bf16_t* W1t = (const bf16_t*)(ws + WS_SMALL + (kv ? SM_WCV1 : SM_WCK1));
    const bf16_t* W2t = (const bf16_t*)(ws + WS_SMALL + (kv ? SM_WCV2 : SM_WCK2));
    bf16_t* outp = (bf16_t*)(ws + (kv ? WS_VCMP : WS_KCMP));
    const int R0 = rt * 32;
    LAS float* red = (LAS float*)F.lds;
    __syncthreads();
    f32x16 acc[4];
#pragma unroll
    for (int nb = 0; nb < 4; ++nb) acc[nb] = f32x16{};
    const bf16_t* ap = Af + (size_t)(R0 + r32) * 2048 + wid * 512 + hi * 8;
    const bf16_t* bp = W1t + (size_t)r32 * 4096 + wid * 512 + hi * 8;
#pragma unroll 8
    for (int ks = 0; ks < 32; ++ks) {
        const bf16x8 a = *(const bf16x8*)(ap + ks * 16);
#pragma unroll
        for (int nb = 0; nb < 4; ++nb) { const bf16x8 b = *(const bf16x8*)(bp + (size_t)nb * 32 * 4096 + ks * 16); acc[nb] = __builtin_amdgcn_mfma_f32_32x32x16_bf16(a, b, acc[nb], 0, 0, 0); }
    }
#pragma unroll
    for (int nb = 0; nb < 4; ++nb)
#pragma unroll
        for (int r = 0; r < 16; ++r) red[(wid * 32 + ((r & 3) + 8 * (r >> 2) + 4 * hi)) * 128 + nb * 32 + r32] = acc[nb][r];
    __syncthreads();
    float hv[8];
    {
        const int n = tid & 127;
        const float pbias = ((const float*)(ws + WS_CTL + CTL_PBSUM))[kv * 128 + n];
#pragma unroll
        for (int e = 0; e < 8; ++e) { const int c = (tid >> 7) * 8 + e; float s = 0.f;
#pragma unroll
            for (int w = 0; w < 8; ++w) s += red[(w * 32 + c) * 128 + n];
            s += pbias; hv[e] = s * __builtin_amdgcn_rcpf(1.0f + __builtin_amdgcn_exp2f(-s * LOG2E)); }
    }
    __syncthreads();
    LAS bf16_t* h1 = (LAS bf16_t*)F.lds;
    { const int n = tid & 127;
#pragma unroll
        for (int e = 0; e < 8; ++e) { const int c = (tid >> 7) * 8 + e; h1[c * 136 + n] = (bf16_t)f2bf(hv[e]); } }
    __syncthreads();
    if (wid < 4) {
        f32x16 o = f32x16{};
#pragma unroll
        for (int ks = 0; ks < 8; ++ks) {
            const bf16x8 a = *(const LAS bf16x8*)(h1 + r32 * 136 + ks * 16 + hi * 8);
            const bf16x8 b = *(const bf16x8*)(W2t + (size_t)(wid * 32 + r32) * 128 + ks * 16 + hi * 8);
            o = __builtin_amdgcn_mfma_f32_32x32x16_bf16(a, b, o, 0, 0, 0);
        }
#pragma unroll
        for (int r = 0; r < 16; ++r) outp[(size_t)(R0 + (r & 3) + 8 * (r >> 2) + 4 * hi) * 128 + wid * 32 + r32] = (bf16_t)f2bf(o[r]);
    }
    __syncthreads();
}

template <int W>
__device__ __forceinline__ void pool_d_seg(const float* ub, bf16_t* db, int t0, int cq) {
    f32x4 ring[W]; f32x4 sum = (f32x4){0.f, 0.f, 0.f, 0.f};
    const int tp0 = t0 & 2047;
#pragma unroll
    for (int i = 0; i < W; ++i) { ring[i] = (tp0 - W + i >= 0) ? *(const f32x4*)(ub + (size_t)(t0 - W + i) * DPOOL + 4 * cq) : (f32x4){0.f, 0.f, 0.f, 0.f}; sum += ring[i]; }
    for (int c0 = 0; c0 < 32; c0 += W) {
#pragma unroll
        for (int i = 0; i < W; ++i) {
            const int t = t0 + c0 + i; const f32x4 x = *(const f32x4*)(ub + (size_t)t * DPOOL + 4 * cq);
            sum = sum + x - ring[i]; ring[i] = x;
            const int tp = tp0 + c0 + i; const float inv = 1.0f / (float)(tp + 1 < W ? tp + 1 : W);
            const f32x4 d = sum * inv - x;
            u32x2 w; w.x = cvt_pk_bf16(d.x, d.y); w.y = cvt_pk_bf16(d.z, d.w);
            *(u32x2*)(db + (size_t)(cq >> 7) * M * 512 + blk_off(t, (4 * cq) & 511, KTP)) = w;
        }
    }
}
__device__ __forceinline__ void pool_d_unit(Frame& F, int seg) {
    const float* ub = (const float*)(F.ws + WS_U); bf16_t* db = (bf16_t*)(F.ws + WS_DPOOL);
    const int cq = F.tid, gi = cq >> 7, t0 = seg * 32;
    if (gi == 0) pool_d_seg<2>(ub, db, t0, cq); else if (gi == 1) pool_d_seg<4>(ub, db, t0, cq); else if (gi == 2) pool_d_seg<8>(ub, db, t0, cq); else pool_d_seg<16>(ub, db, t0, cq);
}

constexpr int SHM_T = 64 * 128 * 2;
constexpr int AT_V = 0  , AT_K = 3 * SHM_T  , AT_WS = 5 * SHM_T  , AT_LUT = AT_WS + 2048  , AT_GL = AT_LUT + 4 * 304 * 4  ;
constexpr int AT_SEL = AT_GL + 3072  , AT_IMPS = AT_SEL + 256  , AT_IMPH = AT_IMPS + 64 * 33 * 4  , AT_END = AT_IMPH + 4 * 64 * 33 * 4;
static_assert(AT_END <= CTRL_OFF, "attention LDS");
#define KSWZ(row, colB) ((row) * 256 + ((colB) ^ (((row) & 7) << 4)))
#define SBAR() __builtin_amdgcn_sched_barrier(0)
__device__ __forceinline__ int v_st(int k, int c) { const int kk = (k & ~0xC) | ((k & 4) << 1) | ((k & 8) >> 1); return ((kk >> 3) * 4 + (c >> 5)) * 512 + ((kk & 7) * 32 + (c & 31)) * 2; }
__device__ __forceinline__ int v_rd_base(int lane) { return ((lane & 3) << 3) | (((lane >> 2) & 3) << 6) | (((lane >> 4) & 1) << 5) | (((lane >> 5) & 1) << 8); }
constexpr int v_rd_off(int d0, int ks, int half) { return d0 * 512 + ks * 4096 + half * 2048; }
__device__ __forceinline__ int crow(int r, int hi) { return (r & 3) + 8 * (r >> 2) + 4 * hi; }

__device__ __forceinline__ void qkt(f32x16& p0, f32x16& p1, const LAS unsigned char* Kt, int r32, int hi, const bf16x8* qr, float init) {
    f32x16 zi;
#pragma unroll
    for (int r = 0; r < 16; ++r) zi[r] = init;
    const int kt = (int)(uintptr_t)Kt;
    const int a0 = kt + KSWZ(r32, (0 * 16 + hi * 8) * 2), a1 = kt + KSWZ(r32, (1 * 16 + hi * 8) * 2), a2 = kt + KSWZ(r32, (2 * 16 + hi * 8) * 2), a3 = kt + KSWZ(r32, (3 * 16 + hi * 8) * 2);
#define DSR128(dst, addr, off) asm volatile("ds_read_b128 %0, %1 offset:%2" : "=&v"(dst) : "v"(addr), "i"(off) : "memory")
    bf16x8 f0, f1, f2, f3, g0, g1, g2, g3, f4, f5, f6, f7, g4, g5, g6, g7;
    DSR128(f0, a0, 0); DSR128(g0, a0, 8192); DSR128(f1, a1, 0); DSR128(g1, a1, 8192); DSR128(f2, a2, 0); DSR128(g2, a2, 8192); DSR128(f3, a3, 0); DSR128(g3, a3, 8192);
    asm volatile("s_waitcnt lgkmcnt(0)" : "+v"(f0), "+v"(g0), "+v"(f1), "+v"(g1), "+v"(f2), "+v"(g2), "+v"(f3), "+v"(g3) :: "memory");
    DSR128(f4, a0, 128); DSR128(g4, a0, 8320); DSR128(f5, a1, 128); DSR128(g5, a1, 8320); DSR128(f6, a2, 128); DSR128(g6, a2, 8320); DSR128(f7, a3, 128); DSR128(g7, a3, 8320);
    SBAR();
    p0 = __builtin_amdgcn_mfma_f32_32x32x16_bf16(f0, qr[0], zi, 0, 0, 0); p1 = __builtin_amdgcn_mfma_f32_32x32x16_bf16(g0, qr[0], zi, 0, 0, 0);
    p0 = __builtin_amdgcn_mfma_f32_32x32x16_bf16(f1, qr[1], p0, 0, 0, 0); p1 = __builtin_amdgcn_mfma_f32_32x32x16_bf16(g1, qr[1], p1, 0, 0, 0);
    p0 = __builtin_amdgcn_mfma_f32_32x32x16_bf16(f2, qr[2], p0, 0, 0, 0); p1 = __builtin_amdgcn_mfma_f32_32x32x16_bf16(g2, qr[2], p1, 0, 0, 0);
    p0 = __builtin_amdgcn_mfma_f32_32x32x16_bf16(f3, qr[3], p0, 0, 0, 0); p1 = __builtin_amdgcn_mfma_f32_32x32x16_bf16(g3, qr[3], p1, 0, 0, 0);
    asm volatile("s_waitcnt lgkmcnt(0)" : "+v"(f4), "+v"(g4), "+v"(f5), "+v"(g5), "+v"(f6), "+v"(g6), "+v"(f7), "+v"(g7) :: "memory");
    SBAR();
    p0 = __builtin_amdgcn_mfma_f32_32x32x16_bf16(f4, qr[4], p0, 0, 0, 0); p1 = __builtin_amdgcn_mfma_f32_32x32x16_bf16(g4, qr[4], p1, 0, 0, 0);
    p0 = __builtin_amdgcn_mfma_f32_32x32x16_bf16(f5, qr[5], p0, 0, 0, 0); p1 = __builtin_amdgcn_mfma_f32_32x32x16_bf16(g5, qr[5], p1, 0, 0, 0);
    p0 = __builtin_amdgcn_mfma_f32_32x32x16_bf16(f6, qr[6], p0, 0, 0, 0); p1 = __builtin_amdgcn_mfma_f32_32x32x16_bf16(g6, qr[6], p1, 0, 0, 0);
    p0 = __builtin_amdgcn_mfma_f32_32x32x16_bf16(f7, qr[7], p0, 0, 0, 0); p1 = __builtin_amdgcn_mfma_f32_32x32x16_bf16(g7, qr[7], p1, 0, 0, 0);
#undef DSR128
}
__device__ __forceinline__ void lut_add(f32x16& p0, f32x16& p1, const LAS float* lb) {
    const int la = (int)(uintptr_t)lb;
    float t0[16], t1[16];
#define DSR32(dst, off) asm volatile("ds_read_b32 %0, %1 offset:%2" : "=&v"(dst) : "v"(la), "i"(off) : "memory")
#define LUT_RD(r) do { constexpr int c_ = ((r) & 3) + 8 * ((r) >> 2); DSR32(t0[r], (59 - c_) * 4); DSR32(t1[r], (27 - c_) * 4); } while (0)
    LUT_RD(0); LUT_RD(1); LUT_RD(2); LUT_RD(3); LUT_RD(4); LUT_RD(5); LUT_RD(6); LUT_RD(7); LUT_RD(8); LUT_RD(9); LUT_RD(10); LUT_RD(11); LUT_RD(12); LUT_RD(13); LUT_RD(14); LUT_RD(15);
#undef LUT_RD
#undef DSR32
    asm volatile("s_waitcnt lgkmcnt(0)" : "+v"(t0[0]), "+v"(t0[1]), "+v"(t0[2]), "+v"(t0[3]), "+v"(t0[4]), "+v"(t0[5]), "+v"(t0[6]), "+v"(t0[7]), "+v"(t0[8]), "+v"(t0[9]), "+v"(t0[10]), "+v"(t0[11]), "+v"(t0[12]), "+v"(t0[13]), "+v"(t0[14]), "+v"(t0[15]) :: "memory");
    asm volatile("" : "+v"(t1[0]), "+v"(t1[1]), "+v"(t1[2]), "+v"(t1[3]), "+v"(t1[4]), "+v"(t1[5]), "+v"(t1[6]), "+v"(t1[7]), "+v"(t1[8]), "+v"(t1[9]), "+v"(t1[10]), "+v"(t1[11]), "+v"(t1[12]), "+v"(t1[13]), "+v"(t1[14]), "+v"(t1[15]) :: "memory");
    SBAR();
#pragma unroll
    for (int r = 0; r < 16; ++r) { p0[r] += t0[r]; p1[r] += t1[r]; }
}
__device__ __forceinline__ void pv_tile(f32x16* o, int vb, bf16x8 pa0, bf16x8 pa1, bf16x8 pa2, bf16x8 pa3) {
#define TRRD(dst, off) asm volatile("ds_read_b64_tr_b16 %0, %1 offset:%2" : "=&v"(dst) : "v"(vb), "i"(off) : "memory")
#define PV_D0(d0) do { s16x4 l0, l1, l2, l3, h0, h1, h2, h3; constexpr int b_ = v_rd_off(d0, 0, 0); \
        TRRD(l0, b_); TRRD(h0, b_ + 2048); TRRD(l1, b_ + 4096); TRRD(h1, b_ + 6144); TRRD(l2, b_ + 8192); TRRD(h2, b_ + 10240); TRRD(l3, b_ + 12288); TRRD(h3, b_ + 14336); \
        asm volatile("s_waitcnt lgkmcnt(0)" ::: "memory"); SBAR(); \
        o[d0] = __builtin_amdgcn_mfma_f32_32x32x16_bf16(pa0, (bf16x8){l0[0], l0[1], l0[2], l0[3], h0[0], h0[1], h0[2], h0[3]}, o[d0], 0, 0, 0); \
        o[d0] = __builtin_amdgcn_mfma_f32_32x32x16_bf16(pa1, (bf16x8){l1[0], l1[1], l1[2], l1[3], h1[0], h1[1], h1[2], h1[3]}, o[d0], 0, 0, 0); \
        o[d0] = __builtin_amdgcn_mfma_f32_32x32x16_bf16(pa2, (bf16x8){l2[0], l2[1], l2[2], l2[3], h2[0], h2[1], h2[2], h2[3]}, o[d0], 0, 0, 0); \
        o[d0] = __builtin_amdgcn_mfma_f32_32x32x16_bf16(pa3, (bf16x8){l3[0], l3[1], l3[2], l3[3], h3[0], h3[1], h3[2], h3[3]}, o[d0], 0, 0, 0); } while (0)
    PV_D0(0); PV_D0(1); PV_D0(2); PV_D0(3);
#undef PV_D0
#undef TRRD
}
__device__ __forceinline__ void pack_p(const f32x16& p0, const f32x16& p1, bf16x8& pa0, bf16x8& pa1, bf16x8& pa2, bf16x8& pa3) {
#define PK4(P, B_, OUT) do { unsigned a0 = cvt_pk_bf16(P[B_+0], P[B_+1]), a1 = cvt_pk_bf16(P[B_+2], P[B_+3]); \
        unsigned b0 = cvt_pk_bf16(P[B_+4], P[B_+5]), b1 = cvt_pk_bf16(P[B_+6], P[B_+7]); \
        auto r0 = __builtin_amdgcn_permlane32_swap(a0, b0, false, false); auto r1 = __builtin_amdgcn_permlane32_swap(a1, b1, false, false); \
        u32x4 w = {r0[0], r1[0], r0[1], r1[1]}; OUT = __builtin_bit_cast(bf16x8, w); } while (0)
    PK4(p0, 0, pa0); PK4(p0, 8, pa1); PK4(p1, 0, pa2); PK4(p1, 8, pa3);
#undef PK4
}
__device__ __forceinline__ float half_swap_max(float v) { auto rr = __builtin_amdgcn_permlane32_swap(__float_as_uint(v), __float_as_uint(v), false, false); return fmaxf(__uint_as_float(rr[0]), __uint_as_float(rr[1])); }
__device__ __forceinline__ float half_swap_sum(float v) { auto rr = __builtin_amdgcn_permlane32_swap(__float_as_uint(v), __float_as_uint(v), false, false); return __uint_as_float(rr[0]) + __uint_as_float(rr[1]); }

struct TileStage { bf16x8 k0, k1, v0, v1; };
__device__ __forceinline__ void tile_load(TileStage& T, const bf16_t* Kp, const bf16_t* Vp, int key0, int sr, int sc) {
    T.k0 = *(const bf16x8*)(Kp + (size_t)(key0 + sr) * HD + sc); T.k1 = *(const bf16x8*)(Kp + (size_t)(key0 + 32 + sr) * HD + sc);
    T.v0 = *(const bf16x8*)(Vp + (size_t)(key0 + sr) * HD + sc); T.v1 = *(const bf16x8*)(Vp + (size_t)(key0 + 32 + sr) * HD + sc);
}
__device__ __forceinline__ void tile_write(const TileStage& T, LAS unsigned char* lds, int kbuf, int vbuf, int sr, int sc) {
    const int kws = KSWZ(sr, sc * 2);
    *(LAS bf16x8*)(lds + AT_K + kbuf * SHM_T + kws) = T.k0; *(LAS bf16x8*)(lds + AT_K + kbuf * SHM_T + kws + 32 * 256) = T.k1;
    *(LAS bf16x8*)(lds + AT_V + vbuf * SHM_T + v_st(sr, sc)) = T.v0; *(LAS bf16x8*)(lds + AT_V + vbuf * SHM_T + v_st(32 + sr, sc)) = T.v1;
}

template <int MODE>
__device__ __forceinline__ void attn_branch(Frame& F, const bf16_t* Kp, const bf16_t* Vp, int j_lo, int j_hi, int sb, const bf16x8* qr, unsigned smask, f32x16* o, float& l_out) {
    int tid = F.tid; asm volatile("" : "+v"(tid));
    const int lane = tid & 63, wid = F.wave, r32 = lane & 31, hi = lane >> 5, hl = wid >> 1, rh = wid & 1;
    const int sr = tid >> 4, sc = (tid & 15) * 8;
    LAS unsigned char* lds = F.lds;
    LAS float* wsf = (LAS float*)(lds + AT_WS) + wid * 64;
    const LAS float* lut = (const LAS float*)(lds + AT_LUT) + hl * 304;
    const int vb0 = (int)(uintptr_t)(lds + AT_V) + v_rd_base(lane);
    const int qpos = 64 * sb + 32 * rh + r32;
    float m_reg = -1e30f, l_reg = 0.f;
#pragma unroll
    for (int d = 0; d < 4; ++d) o[d] = f32x16{};
    const int NT = j_hi - j_lo + 1;
    TileStage T;
    { TileStage T1; tile_load(T, Kp, Vp, j_lo * 64, sr, sc); if (NT > 1) tile_load(T1, Kp, Vp, (j_lo + 1) * 64, sr, sc);
      tile_write(T, lds, 0, 0, sr, sc); if (NT > 1) tile_write(T1, lds, 1, 1, sr, sc); }
    __syncthreads();
#define SEL_INIT(j_) ((MODE == 1) ? ((((smask >> (j_)) & 1u) != 0u) ? 0.f : -__builtin_inff()) : 0.f)
    int vs = 0;
    for (int t = 0; t < NT; ++t) {
        const int j = j_lo + t;
        f32x16 C0, C1;
        qkt(C0, C1, lds + AT_K + (t & 1) * SHM_T, r32, hi, qr, SEL_INIT(j));
        const int dq = qpos - 64 * j - 4 * hi;
        if (64 * (sb - j) + 32 * rh < 176) lut_add(C0, C1, lut + (dq + 37));
        if (j == sb || (MODE == 2 && j == sb - 8)) { const float NEG = -__builtin_inff(); const unsigned W = MODE == 2 ? 512u : 0x40000000u;
#pragma unroll
            for (int r = 0; r < 16; ++r) { const int c = (r & 3) + 8 * (r >> 2);
                if ((unsigned)(dq - c) >= W) C0[r] = NEG;
                if ((unsigned)(dq - c - 32) >= W) C1[r] = NEG; } }
        float pmax = fmaxf(C0[0], C1[0]);
#pragma unroll
        for (int r = 1; r < 16; ++r) pmax = __builtin_fmaxf(__builtin_fmaxf(pmax, C0[r]), C1[r]);
        pmax = half_swap_max(pmax);
        float alpha = 1.f;
        if (!__all(pmax - m_reg <= 6.0f)) { const float mn = fmaxf(m_reg, pmax); alpha = __builtin_amdgcn_exp2f(m_reg - mn); m_reg = mn;
            if (hi == 0) wsf[r32] = alpha;
            LDS_WAIT();
#pragma unroll
            for (int d = 0; d < 4; ++d)
#pragma unroll
                for (int r = 0; r < 16; ++r) o[d][r] *= wsf[crow(r, hi)]; }
        float ps = 0.f;
#pragma unroll
        for (int r = 0; r < 16; ++r) { C0[r] = __builtin_amdgcn_exp2f(C0[r] - m_reg); C1[r] = __builtin_amdgcn_exp2f(C1[r] - m_reg); ps += C0[r] + C1[r]; }
        ps = half_swap_sum(ps);
        l_reg = l_reg * alpha + ps;
        bf16x8 pa0, pa1, pa2, pa3; pack_p(C0, C1, pa0, pa1, pa2, pa3);
        if (t + 2 < NT) tile_load(T, Kp, Vp, (j + 2) * 64, sr, sc);
        SBAR();
        pv_tile(o, vb0 + vs * SHM_T, pa0, pa1, pa2, pa3);
        if (t + 2 < NT) tile_write(T, lds, t & 1, vs == 0 ? 2 : vs - 1, sr, sc);
        __syncthreads();
        vs = vs == 2 ? 0 : vs + 1;
    }
#undef SEL_INIT
    l_out = l_reg;
}
template <int MODE>
__device__ __forceinline__ void emit_scaled(const f32x16* o, float scl, LAS float* wsf, int r32, int hi, float* ya, bf16_t* yp) {
    if (hi == 0) wsf[r32] = scl;
    int oa = (4 * hi) * DATT + r32, ob = (4 * hi) * 64 + r32;
    asm volatile("" : "+v"(oa), "+v"(ob));
    float* yb = ya + oa; bf16_t* ypb = yp + ob;
    float prev[16][4];
    if (MODE >= 1) {
#pragma unroll
        for (int r = 0; r < 16; ++r) { const float* p = yb + (size_t)((r & 3) + 8 * (r >> 2)) * DATT;
#pragma unroll
            for (int d = 0; d < 4; ++d) prev[r][d] = p[d * 32]; }
    }
    LDS_WAIT();
    float sv[16];
#pragma unroll
    for (int r = 0; r < 16; ++r) sv[r] = wsf[crow(r, hi)];
    LDS_WAIT();
#pragma unroll
    for (int r = 0; r < 16; ++r) { const int orow = (r & 3) + 8 * (r >> 2);
        float* p = yb + (size_t)orow * DATT; bf16_t* q = ypb + (size_t)orow * 64;
#pragma unroll
        for (int d = 0; d < 4; ++d) { float v = o[d][r] * sv[r];
            if (MODE >= 1) v += prev[r][d];
            if (MODE <= 1) p[d * 32] = v;
            else { const float vn = __shfl_xor(v, 1); if ((r32 & 1) == 0) *(unsigned*)(q + (d >> 1) * (256 * 64) + (d & 1) * 32) = cvt_pk_bf16(v, vn); } } }
}

__device__ __forceinline__ int rel_bucket(int n) {
    if (n < 16) return n;
    int b = 16; const int thr[15] = {19, 21, 24, 27, 31, 35, 40, 46, 52, 59, 67, 77, 87, 99, 113};
#pragma unroll
    for (int i = 0; i < 15; ++i) b += (n >= thr[i]) ? 1 : 0;
    return b;
}

__device__ __forceinline__ void attn_unit(Frame& F, int b, int g, int sb) {
    int tid = F.tid; asm volatile("" : "+v"(tid));
    const int lane = tid & 63, wid = F.wave, r32 = lane & 31, hi = lane >> 5, hl = wid >> 1, rh = wid & 1;
    const int sr = tid >> 4, sc = (tid & 15) * 8;
    unsigned char* ws = F.ws; LAS unsigned char* lds = F.lds;
    LAS float* wsf = (LAS float*)(lds + AT_WS) + wid * 64;
    LAS float* lutw = (LAS float*)(lds + AT_LUT);
    LAS float* gl = (LAS float*)(lds + AT_GL);
    LAS unsigned* selm = (LAS unsigned*)(lds + AT_SEL);
    LAS float* impS = (LAS float*)(lds + AT_IMPS);
    LAS float* impH = (LAS float*)(lds + AT_IMPH);
    const int h = g * 4 + hl, bg = b * NG + g, row = 32 * rh + r32, pos = 64 * sb + row;
    const size_t kvs = KV_STRIDE_B / 2;
    const bf16_t* kvb = (const bf16_t*)(ws + WS_KV);
    const bf16_t* Ksel = kvb + 2 * kvs + (size_t)bg * SEQ * HD; const bf16_t* Vsel = kvb + 3 * kvs + (size_t)bg * SEQ * HD;
    const bf16_t* Kwin = kvb + 4 * kvs + (size_t)bg * SEQ * HD; const bf16_t* Vwin = kvb + 5 * kvs + (size_t)bg * SEQ * HD;
    const bf16_t* Kc = (const bf16_t*)(ws + WS_KCMP) + (size_t)bg * 128 * HD; const bf16_t* Vc = (const bf16_t*)(ws + WS_VCMP) + (size_t)bg * 128 * HD;
    __syncthreads();
    for (int i = tid; i < 4 * 304; i += 512) { const int hh = i / 304, ix = i % 304; int d = ix - 96; d = d < 0 ? 0 : (d > 127 ? 127 : d);
        const float* tab = INP(16); lutw[i] = (tab[rel_bucket(d) * NH + g * 4 + hh] - tab[31 * NH + g * 4 + hh]) * LOG2E; }
    for (int i = tid; i < 768; i += 512) { const int br = i >> 8, hh = (i >> 6) & 3, rw = i & 63; gl[i] = ((const float*)(ws + WS_GATES))[(size_t)(b * SEQ + 64 * sb + rw) * 48 + br * 16 + g * 4 + hh]; }
    if (tid < 64) selm[tid] = 0u;
    bf16x8 qr[8];
    { const bf16_t* qp = (const bf16_t*)(ws + WS_Q) + ((size_t)(b * NH + h) * SEQ + pos) * HD + hi * 8;
#pragma unroll
        for (int d0 = 0; d0 < 8; ++d0) qr[d0] = *(const bf16x8*)(qp + d0 * 16); }
    { TileStage T0, T1; tile_load(T0, Kc, Vc, 0, sr, sc); tile_load(T1, Kc, Vc, 64, sr, sc); tile_write(T0, lds, 0, 0, sr, sc); tile_write(T1, lds, 1, 1, sr, sc); }
    __syncthreads();
    f32x16 o[4];
    float* ya = (float*)(ws + WS_HID) + (size_t)(b * SEQ + 64 * sb + 32 * rh) * DATT + h * HD;
    bf16_t* yp = (bf16_t*)(ws + WS_YMIX) + blk_off(b * SEQ + 64 * sb + 32 * rh, h * HD, KT4);
    {
        f32x16 cA0, cA1, cB0, cB1;
        qkt(cA0, cA1, lds + AT_K, r32, hi, qr, 0.f);
        qkt(cB0, cB1, lds + AT_K + SHM_T, r32, hi, qr, 0.f);
        const LAS float* lut = lutw + hl * 304;
        const int dqc = pos - 31 - 64 * hi; const float NEG = -__builtin_inff();
        float mx = NEG;
#define CMP_FIX(P, CB) do { _Pragma("unroll") for (int r = 0; r < 16; ++r) { const int c = (CB) + (r & 3) + 8 * (r >> 2); const int dist = dqc - 16 * c; \
            int ix = dist + 96; ix = ix < 0 ? 0 : (ix > 303 ? 303 : ix); const float bv = lut[ix]; P[r] = dist >= 0 ? P[r] + bv : NEG; mx = fmaxf(mx, P[r]); } } while (0)
        CMP_FIX(cA0, 0); CMP_FIX(cA1, 32); CMP_FIX(cB0, 64); CMP_FIX(cB1, 96);
#undef CMP_FIX
        mx = half_swap_max(mx);
        const float mref = (mx == NEG) ? 0.f : mx;
        float ls = 0.f;
#pragma unroll
        for (int r = 0; r < 16; ++r) { cA0[r] = __builtin_amdgcn_exp2f(cA0[r] - mref); cA1[r] = __builtin_amdgcn_exp2f(cA1[r] - mref); cB0[r] = __builtin_amdgcn_exp2f(cB0[r] - mref); cB1[r] = __builtin_amdgcn_exp2f(cB1[r] - mref);
            ls += (cA0[r] + cA1[r]) + (cB0[r] + cB1[r]); }
        ls = half_swap_sum(ls);
        const float inv = ls > 0.f ? 1.0f / ls : 0.f;
#pragma unroll
        for (int r = 0; r < 16; ++r) { cA0[r] *= inv; cA1[r] *= inv; cB0[r] *= inv; cB1[r] *= inv; }
        LAS float* ih = impH + (hl * 64 + row) * 33;
        float lprev = 0.f;
#define IMP_Q(P, QB) do { _Pragma("unroll") for (int i = 0; i < 4; ++i) { const float Gq = (P[4 * i] + P[4 * i + 1]) + (P[4 * i + 2] + P[4 * i + 3]); const float Lq = P[4 * i + 3]; \
            auto rr = __builtin_amdgcn_permlane32_swap(__float_as_uint(Lq), __float_as_uint(Lq), false, false); \
            const float lp_lo = __uint_as_float(rr[0]), lp_hi = __uint_as_float(rr[1]); \
            ih[2 * ((QB) + i) + hi] = Gq + (hi ? lp_lo : lprev); lprev = lp_hi; } } while (0)
        IMP_Q(cA0, 0); IMP_Q(cA1, 4); IMP_Q(cB0, 8); IMP_Q(cB1, 12);
#undef IMP_Q
#pragma unroll
        for (int d = 0; d < 4; ++d) o[d] = f32x16{};
        const int vb0 = (int)(uintptr_t)(lds + AT_V) + v_rd_base(lane);
        { bf16x8 pa0, pa1, pa2, pa3; pack_p(cA0, cA1, pa0, pa1, pa2, pa3); SBAR(); pv_tile(o, vb0, pa0, pa1, pa2, pa3); }
        { bf16x8 pa0, pa1, pa2, pa3; pack_p(cB0, cB1, pa0, pa1, pa2, pa3); SBAR(); pv_tile(o, vb0 + SHM_T, pa0, pa1, pa2, pa3); }
        emit_scaled<0>(o, gl[0 * 256 + hl * 64 + row], wsf, r32, hi, ya, yp);
    }
    __syncthreads();
    {
        const int rw = tid >> 3, jg = tid & 7;
#pragma unroll
        for (int e = 0; e < 4; ++e) { const int j = 4 * jg + e; impS[rw * 33 + j] = (impH[(0 * 64 + rw) * 33 + j] + impH[(1 * 64 + rw) * 33 + j]) + (impH[(2 * 64 + rw) * 33 + j] + impH[(3 * 64 + rw) * 33 + j]); }
        __syncthreads();
        unsigned bits = 0u;
        if (sb <= 7) {
#pragma unroll
            for (int e = 0; e < 4; ++e) { const int j = 4 * jg + e; if (j <= sb) bits |= 1u << j; }
        } else {
            float v[32];
#pragma unroll
            for (int i = 0; i < 32; ++i) v[i] = impS[rw * 33 + i];
#pragma unroll
            for (int e = 0; e < 4; ++e) { const int j = 4 * jg + e; float vj = 0.f;
#pragma unroll
                for (int i = 0; i < 32; ++i) vj = (i == j) ? v[i] : vj;
                int rank = 0;
#pragma unroll
                for (int i = 1; i < 32; ++i) { const bool cand = i <= sb - 2; rank += (cand && (v[i] > vj || (v[i] == vj && i < j))) ? 1 : 0; }
                const bool candj = j >= 1 && j <= sb - 2;
                if ((candj && rank < 5) || j == 0 || j == sb || j == sb - 1) bits |= 1u << j; }
        }
        bits |= __shfl_xor(bits, 1); bits |= __shfl_xor(bits, 2); bits |= __shfl_xor(bits, 4);
        if (jg == 0) selm[rw] = bits;
    }
    __syncthreads();
    const unsigned smask = selm[row];
    float l2;
    attn_branch<1>(F, Ksel, Vsel, 0, sb, sb, qr, smask, o, l2);
    emit_scaled<1>(o, gl[1 * 256 + hl * 64 + row] / l2, wsf, r32, hi, ya, yp);
    float l3;
    attn_branch<2>(F, Kwin, Vwin, sb >= 8 ? sb - 8 : 0, sb, sb, qr, 0u, o, l3);
    emit_scaled<2>(o, gl[2 * 256 + hl * 64 + row] / l3, wsf, r32, hi, ya, yp);
}

constexpr int PER_PHASE = 10;
constexpr int N_LAUNCHES = MK_N_LAUNCHES;
struct Args { const float* in[22]; float* out; unsigned char* ws; int ph_lo, ph_hi, li, pad; };
__global__ void __launch_bounds__(512, 2) mk_fwd(Args args) {
    extern __shared__ __attribute__((aligned(16))) unsigned char lds_raw[];
    Frame F;
    F.lds = (LAS unsigned char*)lds_raw;
    F.tid = threadIdx.x; F.wave = __builtin_amdgcn_readfirstlane(F.tid >> 6);
    F.G = gridDim.x; { const int bx = blockIdx.x; F.vcu = (F.G % 8 == 0) ? (bx % 8) * (F.G / 8) + bx / 8 : bx; }
    F.out = args.out; F.ws = args.ws;
    unsigned char* ws = args.ws;
    volatile LAS unsigned* MISC = (volatile LAS unsigned*)(F.lds + MISC_OFF);
    for (int u = F.tid; u < (LDS_BYTES - CTRL_OFF) / 4; u += 512) ((LAS unsigned*)(F.lds + CTRL_OFF))[u] = 0u;
    __syncthreads();
    if (F.tid < 22) *(LAS u64*)(F.lds + PTR_OFF + 8 * F.tid) = (u64)(uintptr_t)args.in[F.tid];
    __syncthreads();
    unsigned* ctl = (unsigned*)(ws + WS_CTL);
    XcdBarrier bar; bar.bar = ctl + CW_BAR + args.li * XCD_BAR_WORDS; bar.x = 0; bar.st = nullptr;
    if (N_LAUNCHES != PER_PHASE) bar = xcd_barrier_post(ctl + CW_BAR + args.li * XCD_BAR_WORDS, MISC + 8);
    const int lo = args.ph_lo, hi = args.ph_hi;
#ifndef PH_MASK
#define PH_MASK 0x3ff
#endif
#define IN(k) (((PH_MASK >> (k)) & 1) && lo <= (k) && (k) < hi)
#define BOTH(k) (IN(k) && IN((k) + 1))
#define GRID_BAR() do { if (N_LAUNCHES != PER_PHASE) xcd_barrier(bar); } while (0)
    u64* racc1 = (u64*)(ws + WS_CTL + CTL_RACC); u64* racc2 = racc1 + M; u64* racc3 = racc2 + M;
    bf16_t* actb = (bf16_t*)(ws + WS_ACTB); bf16_t* hid = (bf16_t*)(ws + WS_HID);

    static_assert(N_LAUNCHES == 1, "phases 0 and 6 contain an in-phase grid barrier");
    if (IN(0)) { gu_absmax<ROT2>(F, GU_STRIPS, GU_STRIPS_ALL); gu_absmax<ROT1>(F, GU_STRIPS_ALL, GU_STRIPS_ALL + 1408); gu_absmax<0>(F, 2752, GU_STRIPS); GRID_BAR(); p0_prologue(F); if (BOTH(0)) GRID_BAR(); }

    if (IN(1)) {
        pg8::Gemm g{ws + WS_XQ, ws + WS_WGU1, DM, 1}; pg8::StaticOrder S; S.init(M, NGU, F.G, (int)blockIdx.x);
        EpiSwiGLUQ<false> E{hid, (const float*)(ws + WS_SMALL + SM_RA0), (const float*)(ws + WS_SMALL + SM_SB1), nullptr};
        pg8::gemm_phase<EpiSwiGLUQ<false>, pg8::StaticOrder, true>(F.lds, g, S, E);
        { const int r = S.nwg % F.G;
          if ((int)blockIdx.x == r && F.tid < 256) { const int kv = F.tid >> 7, n = F.tid & 127; const float* pb = (const float*)(ws + WS_SMALL + SM_PBP) + (size_t)kv * 128 * 128 + n;
              float sacc = 0.f; for (int ch = 0; ch < 128; ++ch) sacc += pb[ch * 128];
              ((float*)(ws + WS_CTL + CTL_PBSUM))[kv * 128 + n] = sacc; } }
        tail_quant<ROT1>(F, S.nwg, Q_R_D1Q + 5408, Q_R_D1Q + P0_I_D);
        GRID_BAR();
        quant_hid_rot<ROT1>(F, hid, ws + WS_HIDQ, (float*)(ws + WS_SMALL + SM_SH));
        if (BOTH(1)) GRID_BAR();
    }
    if (IN(2)) {
        pg8::Gemm g{ws + WS_HIDQ, ws + WS_WD1, FF, 1}; pg8::StaticOrder S; S.init(M, DM, F.G, (int)blockIdx.x);
        EpiResidQ E{INP(0), F.out, racc1, (const float*)(ws + WS_SMALL + SM_SH), (const float*)(ws + WS_SMALL + SM_SB4), 0.5f, actb};
        pg8::gemm_phase<EpiResidQ, pg8::StaticOrder, true>(F.lds, g, S, E);
        if (BOTH(2)) GRID_BAR();
    }
    if (IN(3)) {
        pg8::Gemm g{actb, ws + WS_WIN, DM, 2}; pg8::StaticOrder S; S.init(M, NINP, F.G, (int)blockIdx.x);
        EpiWin E{(bf16_t*)(ws + WS_Q), (bf16_t*)(ws + WS_KV), (float*)(ws + WS_U), (float*)(ws + WS_GATES), racc1, KV_STRIDE_B / 2};
        pg8::gemm_phase(F.lds, g, S, E);
        tail_convert(F, S.nwg, P0_R_OUT, P0_R_SMALL);
        tail_quant<ROT2>(F, S.nwg, Q_R_D2 + 1708, Q_R_D2 + 5408);
        tail_quant(F, S.nwg, P0_R_GU2, P0_R_GU2 + 7500);
        if (PROBE_DUP == 3) { GRID_BAR(); pg8::gemm_phase(F.lds, g, S, E); }
        if (BOTH(3)) GRID_BAR();
    }
    if (IN(4)) {
        for (int u = blockIdx.x; u < 128; u += F.G) compress_unit(F, u >> 6, u & 63);
        for (int u = blockIdx.x; u < 256; u += F.G) pool_d_unit(F, u);
        __syncthreads();
        if (F.G > 128) { if ((int)blockIdx.x >= 128) gu_quant(F, P0_R_GU2 + 7500, P0_R_D1, (int)blockIdx.x - 128, F.G - 128); }
        else gu_quant(F, P0_R_GU2 + 7500, P0_R_D1, (int)blockIdx.x, F.G);
        if (PROBE_DUP == 4) { GRID_BAR(); for (int u = blockIdx.x; u < 128; u += F.G) compress_unit(F, u >> 6, u & 63); for (int u = blockIdx.x; u < 256; u += F.G) pool_d_unit(F, u); }
        if (BOTH(4)) GRID_BAR();
    }
    if (IN(5)) {
        { pg8::Gemm g{ws + WS_DPOOL, ws + WS_SMALL + SM_WPOOL, 512, 2}; pg8::PoolOrder S{F.G, (int)blockIdx.x};
          EpiPool E{(bf16_t*)(ws + WS_YMIX), INP(14)};
          pg8::gemm_phase(F.lds, g, S, E); }
        for (int u = blockIdx.x; u < 256; u += F.G) {
            const int x = u & 7, k = u >> 3, bg = 2 * x + (k & 1), pr = k >> 1;
            attn_unit(F, bg >> 2, bg & 3, 31 - pr);
            attn_unit(F, bg >> 2, bg & 3, pr);
        }
        if (PROBE_DUP == 5) { GRID_BAR(); for (int u = blockIdx.x; u < 256; u += F.G) { const int x = u & 7, k = u >> 3, bg = 2 * x + (k & 1), pr = k >> 1; attn_unit(F, bg >> 2, bg & 3, 31 - pr); attn_unit(F, bg >> 2, bg & 3, pr); } }
        if (BOTH(5)) GRID_BAR();
    }
    if (IN(6)) {
        pg8::Gemm g{ws + WS_YMIX, ws + WS_WOUT, DM, 2}; pg8::StaticOrder S; S.init(M, DM, F.G, (int)blockIdx.x);
        EpiResid E{F.out, F.out, nullptr, nullptr, 1.0f};
        pg8::gemm_phase(F.lds, g, S, E);
        GRID_BAR();
        quant_rows(F, F.out, ws + WS_XQ, (float*)(ws + WS_SMALL + SM_RA2));
        if (BOTH(6)) GRID_BAR();
    }
    if (IN(7)) {
        pg8::Gemm g{ws + WS_XQ, ws + WS_WGU2, DM, 1}; pg8::StaticOrder S; S.init(M, NGU, F.G, (int)blockIdx.x);
        EpiSwiGLUQ<false> E{hid, (const float*)(ws + WS_SMALL + SM_RA2), (const float*)(ws + WS_SMALL + SM_SB2), nullptr};
        pg8::gemm_phase<EpiSwiGLUQ<false>, pg8::StaticOrder, true>(F.lds, g, S, E);
        tail_quant<ROT2>(F, S.nwg, Q_R_D2 + 5408, Q_R_D2 + P0_I_D);
        GRID_BAR();
        quant_hid_rot<ROT2>(F, hid, ws + WS_HIDQ, (float*)(ws + WS_SMALL + SM_SH));
        if (BOTH(7)) GRID_BAR();
    }
    if (IN(8)) {
        pg8::Gemm g{ws + WS_HIDQ, ws + WS_WD2, FF, 1}; pg8::StaticOrder S; S.init(M, DM, F.G, (int)blockIdx.x);
        EpiResidQ E{F.out, nullptr, racc3, (const float*)(ws + WS_SMALL + SM_SH), (const float*)(ws + WS_SMALL + SM_SB3), 0.5f, actb};
        pg8::gemm_phase<EpiResidQ, pg8::StaticOrder, true>(F.lds, g, S, E);
        if (BOTH(8)) GRID_BAR();
    }
    if (IN(9)) {
        const int gw = F.vcu * 8 + F.wave, NGW = F.G * 8, lane = (F.tid & 63), kq = lane >> 3, c = lane & 7;
        const float* gn = INP(21);
        for (int m = gw; m < M; m += NGW) {
            const float r = rs_from_acc(racc3[m]);
            const bf16_t* src = actb + blk_off(m, 64 * kq, KT4) + 8 * c;
            u32x4 v[8];
#pragma unroll
            for (int j = 0; j < 8; ++j) v[j] = *(const u32x4*)(src + (size_t)(8 * j) * (256 * 64));
#pragma unroll
            for (int j = 0; j < 8; ++j) {
                const int k = 64 * (8 * j + kq) + 8 * c;
                const f32x4 g0 = *(const f32x4*)(gn + k), g1 = *(const f32x4*)(gn + k + 4);
                f32x4 o0, o1;
                o0[0] = __uint_as_float(v[j].x << 16); o0[1] = __uint_as_float(v[j].x & 0xffff0000u); o0[2] = __uint_as_float(v[j].y << 16); o0[3] = __uint_as_float(v[j].y & 0xffff0000u);
                o1[0] = __uint_as_float(v[j].z << 16); o1[1] = __uint_as_float(v[j].z & 0xffff0000u); o1[2] = __uint_as_float(v[j].w << 16); o1[3] = __uint_as_float(v[j].w & 0xffff0000u);
                float* dst = F.out + (size_t)m * DM + k;
                *(f32x4*)dst = o0 * r * g0; *(f32x4*)(dst + 4) = o1 * r * g1;
            }
        }
    }
#undef IN
#undef BOTH
#undef GRID_BAR
}

extern "C" void kernel_launch(void* const* d_in, const int* in_sizes, int n_in, void* d_out, int out_size, void* d_ws, size_t ws_size, hipStream_t stream) {
    static int grid = 0;
    if (grid == 0) {
        if (n_in != 22 || in_sizes[0] != M * DM || out_size != M * DM || ws_size < WS_END3) { fprintf(stderr, "kernel_launch: unexpected shapes (n_in %d, in0 %d, out %d, ws %zu < %zu); nothing launched\n", n_in, n_in > 0 ? in_sizes[0] : -1, out_size, ws_size, (size_t)WS_END3); grid = -1; return; }
        int dev = 0, cus = 0, per_cu = 0;
        if (hipGetDevice(&dev) != hipSuccess || hipDeviceGetAttribute(&cus, hipDeviceAttributeMultiprocessorCount, dev) != hipSuccess) { grid = -1; return; }
        if (hipFuncSetAttribute((const void*)mk_fwd, hipFuncAttributeMaxDynamicSharedMemorySize, LDS_BYTES) != hipSuccess) { fprintf(stderr, "kernel_launch: hipFuncSetAttribute failed\n"); grid = -1; return; }
        if (hipOccupancyMaxActiveBlocksPerMultiprocessor(&per_cu, (const void*)mk_fwd, 512, LDS_BYTES) != hipSuccess || per_cu < 1) fprintf(stderr, "kernel_launch: occupancy query says %d\n", per_cu);
        (void)hipGetLastError();
        grid = cus;
    }
    if (grid < 0) return;
    if (hipMemsetAsync((char*)d_ws + WS_CTL, 0, CTL_ZERO_BYTES, stream) != hipSuccess) { fprintf(stderr, "kernel_launch: memset failed\n"); return; }
    Args a{};
    for (int i = 0; i < 22; ++i) a.in[i] = (const float*)d_in[i];
    a.out = (float*)d_out; a.ws = (unsigned char*)d_ws;
    for (int li = 0; li < N_LAUNCHES; ++li) {
        if (N_LAUNCHES == PER_PHASE) { a.ph_lo = li; a.ph_hi = li + 1; a.li = 0; }
        else { a.ph_lo = li * PER_PHASE / N_LAUNCHES; a.ph_hi = (li + 1) * PER_PHASE / N_LAUNCHES; a.li = li; }
        hipLaunchKernelGGL(mk_fwd, dim3(grid), dim3(512), LDS_BYTES, stream, a);
        const hipError_t le = hipPeekAtLastError();
        if (le != hipSuccess) { fprintf(stderr, "kernel_launch: launch %d failed: %s\n", li, hipGetErrorName(le)); break; }
    }
}
```
